# Optimizing an MI355X kernel written in HIP

```python
import math
import jax, jax.numpy as jnp
from jax import lax
import numpy as np

D_MODEL = 2048
BATCH = 2
SEQ = 4096
DEPTH = 2

POOL_GROUPS = 4
POOL_WINDOWS = (2, 4, 8, 16)
POOL_WIDTH = D_MODEL // 2
POOL_GROUP_DIM = POOL_WIDTH // POOL_GROUPS
SB_HEADS = 8
SB_HEAD_DIM = 128
SB_WIDTH = SB_HEADS * SB_HEAD_DIM
Q_BLOCK = 128
N_BRANCHES = 2
IN_COLS = POOL_WIDTH + 3 * SB_WIDTH + N_BRANCHES * D_MODEL
D_FF = ((8 * D_MODEL // 3 + 255) // 256) * 256
N_EXPERTS = 8
TOP_K = 2
N_DENSE = (DEPTH + 1) // 2
N_MOE = DEPTH // 2
RMS_EPS = 1e-6

kernel_name = "hybrid_pool_stickbreak_gated_moe"


def rms_norm(x, g):
    xf = x.astype(jnp.float32)
    y = xf * lax.rsqrt(jnp.mean(xf * xf, axis=-1, keepdims=True) + RMS_EPS)
    return (y * g.astype(jnp.float32)).astype(x.dtype)


def causal_multiscale_pool(u, pool_w, pool_scale):
    B, S, _ = u.shape
    uf = u.astype(jnp.float32)
    cs = jnp.pad(jnp.cumsum(uf, axis=1), ((0, 0), (1, 0), (0, 0)))
    pos = jnp.arange(S, dtype=jnp.float32) + 1.0
    group_outs = []
    for gi, w in enumerate(POOL_WINDOWS):
        c0, c1 = gi * POOL_GROUP_DIM, (gi + 1) * POOL_GROUP_DIM
        csg = cs[:, :, c0:c1]
        hi = csg[:, 1:]
        lo = jnp.pad(csg[:, :S + 1 - w], ((0, 0), (w - 1, 0), (0, 0)))
        count = jnp.minimum(pos, float(w))[None, :, None]
        group_outs.append((hi - lo) / count - uf[:, :, c0:c1])
    pooled = jnp.stack(group_outs, axis=2)
    mixed = jnp.einsum('bsgc,gcd->bsgd', pooled, pool_w.astype(jnp.float32))
    out = mixed.reshape(B, S, POOL_WIDTH) * pool_scale.astype(jnp.float32)
    return out.astype(u.dtype)


def stick_breaking_attention(q, k, v):
    S = q.shape[2]
    scale = 1.0 / math.sqrt(SB_HEAD_DIM)
    outs = []
    for start in range(0, S, Q_BLOCK):
        end = start + Q_BLOCK
        qb = q[:, :, start:end]
        kb = k[:, :, :end]
        vb = v[:, :, :end]
        z = jnp.einsum('bhqd,bhkd->bhqk', qb, kb,
                       preferred_element_type=jnp.float32) * scale
        q_pos = start + jnp.arange(Q_BLOCK)[:, None]
        k_pos = jnp.arange(end)[None, :]
        causal = k_pos < q_pos
        log_not = jnp.where(causal, jax.nn.log_sigmoid(-z), 0.0)
        suffix = lax.cumsum(log_not, axis=3, reverse=True)
        log_a = jnp.where(causal, z + suffix, -jnp.inf)
        a = jnp.exp(log_a)
        outs.append(jnp.einsum('bhqk,bhkd->bhqd', a.astype(v.dtype), vb))
    return jnp.concatenate(outs, axis=2)


def hybrid_mixer(h, w_in, pool_w, pool_scale, w_pool_up, w_attn_up, w_out):
    B, S, _ = h.shape
    proj = h @ w_in
    splits = [POOL_WIDTH, POOL_WIDTH + SB_WIDTH, POOL_WIDTH + 2 * SB_WIDTH,
              POOL_WIDTH + 3 * SB_WIDTH]
    u_pool, q, k, v, gate_logits = jnp.split(proj, splits, axis=-1)
    y_pool = causal_multiscale_pool(u_pool, pool_w, pool_scale)
    to_heads = lambda t: t.reshape(B, S, SB_HEADS, SB_HEAD_DIM).transpose(0, 2, 1, 3)
    y_attn = stick_breaking_attention(to_heads(q), to_heads(k), to_heads(v))
    y_attn = y_attn.transpose(0, 2, 1, 3).reshape(B, S, SB_WIDTH)
    gates = jax.nn.sigmoid(gate_logits.reshape(B, S, N_BRANCHES, D_MODEL))
    merged = gates[:, :, 0] * (y_pool @ w_pool_up) + gates[:, :, 1] * (y_attn @ w_attn_up)
    return merged @ w_out


def swiglu(h, w_gate, w_up, w_down):
    return (jax.nn.silu(h @ w_gate) * (h @ w_up)) @ w_down


def moe_swiglu(h, w_router, we_gate, we_up, we_down):
    B, S, D = h.shape
    t = h.reshape(B * S, D)
    logits = (t @ w_router).astype(jnp.float32)
    top_vals, top_idx = lax.top_k(logits, TOP_K)
    top_w = jax.nn.softmax(top_vals, axis=-1)
    combine = jnp.sum(jax.nn.one_hot(top_idx, N_EXPERTS, dtype=jnp.float32)
                      * top_w[..., None], axis=1)
    out = jnp.zeros_like(t)
    for e in range(N_EXPERTS):
        ye = swiglu(t, we_gate[e], we_up[e], we_down[e])
        out = out + combine[:, e:e + 1].astype(t.dtype) * ye
    return out.reshape(B, S, D)


def setup_inputs(seed: int = 0) -> dict:
    key = jax.random.key(seed)
    ks = jax.random.split(key, 20)
    nrm = lambda k, shape, fan_in: jax.random.normal(k, shape, jnp.float32) * (fan_in ** -0.5)
    gain = lambda k, shape: 1.0 + 0.02 * jax.random.normal(k, shape, jnp.float32)
    return {
        "x": jax.random.normal(ks[0], (BATCH, SEQ, D_MODEL), jnp.float32),
        "norm_mix": gain(ks[1], (DEPTH, D_MODEL)),
        "w_in": nrm(ks[2], (DEPTH, D_MODEL, IN_COLS), D_MODEL),
        "pool_w": nrm(ks[3], (DEPTH, POOL_GROUPS, POOL_GROUP_DIM, POOL_GROUP_DIM), POOL_GROUP_DIM),
        "pool_scale": gain(ks[4], (DEPTH, POOL_WIDTH)),
        "w_pool_up": nrm(ks[5], (DEPTH, POOL_WIDTH, D_MODEL), POOL_WIDTH),
        "w_attn_up": nrm(ks[6], (DEPTH, SB_WIDTH, D_MODEL), SB_WIDTH),
        "w_out": nrm(ks[7], (DEPTH, D_MODEL, D_MODEL), D_MODEL),
        "norm_ffn": gain(ks[8], (DEPTH, D_MODEL)),
        "ffn_gate": nrm(ks[9], (N_DENSE, D_MODEL, D_FF), D_MODEL),
        "ffn_up": nrm(ks[10], (N_DENSE, D_MODEL, D_FF), D_MODEL),
        "ffn_down": nrm(ks[11], (N_DENSE, D_FF, D_MODEL), D_FF),
        "w_router": nrm(ks[12], (N_MOE, D_MODEL, N_EXPERTS), D_MODEL),
        "moe_gate": nrm(ks[13], (N_MOE, N_EXPERTS, D_MODEL, D_FF), D_MODEL),
        "moe_up": nrm(ks[14], (N_MOE, N_EXPERTS, D_MODEL, D_FF), D_MODEL),
        "moe_down": nrm(ks[15], (N_MOE, N_EXPERTS, D_FF, D_MODEL), D_FF),
        "norm_final": gain(ks[16], (D_MODEL,)),
    }


def reference(x, norm_mix, w_in, pool_w, pool_scale, w_pool_up, w_attn_up, w_out,
              norm_ffn, ffn_gate, ffn_up, ffn_down, w_router, moe_gate, moe_up,
              moe_down, norm_final):
    for i in range(DEPTH):
        h = rms_norm(x, norm_mix[i])
        x = x + hybrid_mixer(h, w_in[i], pool_w[i], pool_scale[i],
                             w_pool_up[i], w_attn_up[i], w_out[i])
        h = rms_norm(x, norm_ffn[i])
        j = i // 2
        if i % 2 == 0:
            x = x + swiglu(h, ffn_gate[j], ffn_up[j], ffn_down[j])
        else:
            x = x + moe_swiglu(h, w_router[j], moe_gate[j], moe_up[j], moe_down[j])
    return rms_norm(x, norm_final)
```

```cpp
#include <hip/hip_runtime.h>
#include <cstdio>
#include <cstdint>

#ifndef PROBE_DUP
#define HK_TPU 4
#define MOE_STG 11264
#define STRIPS_HOSTED 1
#define STG_MASK 9
#define HK_MASK 0
#define PROBE_DUP 0
#endif
#ifndef MK_PER_PHASE
#define MK_PER_PHASE 0
#endif

namespace pg8 {
#define PG8_LAS __attribute__((address_space(3)))
typedef unsigned short bf16_t;
typedef short bf16x8 __attribute__((ext_vector_type(8)));
typedef float f32x4 __attribute__((ext_vector_type(4)));
typedef float f32x2 __attribute__((ext_vector_type(2)));
typedef unsigned u32x4 __attribute__((ext_vector_type(4)));
typedef unsigned u32x2 __attribute__((ext_vector_type(2)));
typedef int i32x4 __attribute__((ext_vector_type(4)));
typedef int i32x8 __attribute__((ext_vector_type(8)));
constexpr int BM = 256, BK = 64, HALF = 128, HTB = HALF * BK * 2, STAGE_BYTES = 8 * HTB, NXCD = 8, WGM = 8;

__device__ __forceinline__ int lane_id_now() { int l; asm volatile("v_mbcnt_lo_u32_b32 %0, -1, 0\n\tv_mbcnt_hi_u32_b32 %0, -1, %0" : "=v"(l)); return l; }
__host__ __device__ __forceinline__ int lds_byte(int r, int c) { const int st = (r >> 4) * 2 + (c >> 5), rr = r & 15, cc = c & 31, ob = rr * 64 + cc * 2; return st * 1024 + (ob ^ (((ob >> 9) & 1) << 5)); }
__host__ __device__ __forceinline__ void stage_rc(int b, int& R, int& C) { const int st = b / 1024, sb = b % 1024, swz = sb ^ (((sb >> 9) & 1) << 5); R = (st >> 1) * 16 + swz / 64; C = (st & 1) * 32 + (swz % 64) / 2; }
__host__ __device__ __forceinline__ int perm32(int rho) { const int n = rho >> 4, i = rho & 15; return 8 * (i >> 2) + 4 * n + (i & 3); }

struct Unit { int pm, pn; size_t aoff, boff; int nkt, part, gbase; };

template <int NM, int NN, int LDA, int LDB, int APN> struct StaticOrder {
    int G, c;
    __device__ __forceinline__ bool next(int i, Unit& u) const {
        constexpr int nwg = NM * NN;
        const int L = i * G + c; if (L >= nwg) return false;
        int wgid = L; { constexpr int q = nwg / NXCD, r = nwg % NXCD; const int xcd = wgid % NXCD, off = wgid / NXCD; wgid = (xcd < r ? xcd * (q + 1) : r * (q + 1) + (xcd - r) * q) + off; }
        constexpr int nig = WGM * NN; const int gid = wgid / nig, fm = gid * WGM, gsz = (NM - fm) < WGM ? (NM - fm) : WGM;
        u.pm = fm + ((wgid % nig) % gsz); u.pn = (wgid % nig) / gsz;
        u.aoff = (size_t)u.pm * ((size_t)BM * LDA * 2) + (size_t)u.pn * APN; u.boff = (size_t)u.pn * ((size_t)BM * LDB * 2); return true;
    }
};
template <int NN, int LDA, int LDB, size_t BEXP> struct MoeOrder {
    int G, c; int ts[9]; const int* inv;
    __device__ __forceinline__ bool next(int i, Unit& u) const {
        const int L = i * G + c; if (L >= ts[8] * NN) return false;
        int e = 0, s0 = ts[0], s1 = ts[1];
#pragma unroll
        for (int j = 1; j < 8; ++j) if (L >= ts[j] * NN) { e = j; s0 = ts[j]; s1 = ts[j + 1]; }
        const int Le = L - s0 * NN, tc = s1 - s0, pn = Le / tc, tm = Le - pn * tc;
        u.pm = s0 + tm; u.pn = pn; u.aoff = (size_t)u.pm * ((size_t)BM * LDA * 2); u.boff = (size_t)e * BEXP + (size_t)pn * ((size_t)BM * LDB * 2); u.gbase = e * 8192 + tm * BM; return true;
    }
};

template <int NN, int LDA, int LDB, int KP, size_t BEXP, int KS = 2> struct SplitKOrder {
    int G, c; int ts[9];
    __device__ __forceinline__ bool next(int i, Unit& u) const {
        const int U = ts[8] * NN; int L = i * G + c; if (L >= KS * U) return false;
        const int part = (KS == 2 && L >= U) ? 1 : 0; L -= part * U;
        int e = 0, s0 = ts[0], s1 = ts[1];
#pragma unroll
        for (int j = 1; j < 8; ++j) if (L >= ts[j] * NN) { e = j; s0 = ts[j]; s1 = ts[j + 1]; }
        const int Le = L - s0 * NN, tc = s1 - s0, pn = Le / tc, tm = Le - pn * tc;
        constexpr int KH = KP / KS;
        u.pm = s0 + tm; u.pn = pn; u.nkt = 2 * KH; u.part = part;
        u.aoff = (size_t)u.pm * ((size_t)BM * LDA * 2) + (size_t)part * KH * 256; u.boff = (size_t)e * BEXP + (size_t)pn * ((size_t)BM * LDB * 2) + (size_t)part * KH * 256; return true;
    }
};

constexpr int TAIL_MAX_SPLIT = 8;
template <int NN, int LDA, int LDB, int KP, size_t BEXP> struct TailSplitOrder {
    int G, c; int ts[9];
    __device__ __forceinline__ void tail_split(int& F, int& R, int& sp) const { const int U = ts[8] * NN; F = (U / G) * G; R = U - F; sp = R > 0 ? G / R : 1; sp = sp > TAIL_MAX_SPLIT ? TAIL_MAX_SPLIT : sp; }
    __device__ __forceinline__ bool next(int i, Unit& u) const {
        int F, R, sp; tail_split(F, R, sp);
        int L, kp0 = 0, kpn = KP, part = 0;
        if (i * G < F) L = i * G + c;
        else if (i * G == F && R > 0) { if (c >= R * sp) return false; const int r = c % R, p = c / R; L = F + r; kp0 = (p * KP) / sp; kpn = ((p + 1) * KP) / sp - kp0; part = sp > 1 ? 1 + r * sp + p : 0; }
        else return false;
        int e = 0, s0 = ts[0], s1 = ts[1];
#pragma unroll
        for (int j = 1; j < 8; ++j) if (L >= ts[j] * NN) { e = j; s0 = ts[j]; s1 = ts[j + 1]; }
        const int Le = L - s0 * NN, tc = s1 - s0, pn = Le / tc, tm = Le - pn * tc;
        u.pm = s0 + tm; u.pn = pn; u.nkt = 2 * kpn; u.part = part;
        u.aoff = (size_t)u.pm * ((size_t)BM * LDA * 2) + (size_t)kp0 * 256; u.boff = (size_t)e * BEXP + (size_t)pn * ((size_t)BM * LDB * 2) + (size_t)kp0 * 256; return true;
    }
};

__device__ __forceinline__ unsigned cvt_pk_bf16(float lo, float hi) { unsigned r; asm volatile("v_cvt_pk_bf16_f32 %0, %1, %2" : "=v"(r) : "v"(lo), "v"(hi)); return r; }
__device__ __forceinline__ float bf_lo(unsigned w) { return __uint_as_float(w << 16); }
__device__ __forceinline__ float bf_hi(unsigned w) { return __uint_as_float(w & 0xffff0000u); }
__device__ __forceinline__ float sigmoidf_(float x) { return __builtin_amdgcn_rcpf(1.0f + __builtin_amdgcn_exp2f(-1.4426950408889634f * x)); }

struct EpiProj {
    static constexpr bool PERM = true; static constexpr bool PRE = true;
    bf16_t *upool, *q, *k2, *v3, *gates; const float* rowscale; const unsigned* colmax;
    struct Pre { u32x4 cm[2][2]; float rs[2][4]; };
    __device__ __forceinline__ void pre(const Unit& u, int wr, int wc, Pre& P) const {
        const int lane_ = lane_id_now(); const int fr = lane_ & 15, fq = lane_ >> 4;
#pragma unroll
        for (int bj = 0; bj < 2; ++bj)
#pragma unroll
            for (int n = 0; n < 2; ++n) P.cm[bj][n] = *(const u32x4*)(colmax + u.pn * BM + bj * HALF + wc * 32 + 8 * fq + 4 * n);
#pragma unroll
        for (int ai = 0; ai < 2; ++ai)
#pragma unroll
            for (int m = 0; m < 4; ++m) P.rs[ai][m] = rowscale[u.pm * BM + wr * 64 + fr + ai * HALF + m * 16];
    }
    __device__ __forceinline__ void operator()(const f32x4 (&acc_in)[2][2][4][2], const Unit& u, int wr, int wc, const Pre& P) const {
        const int lane_ = lane_id_now(); const int fr = lane_ & 15, fq = lane_ >> 4;
        const int pn = u.pn, row0 = u.pm * BM + wr * 64 + fr;
        f32x4 acc[2][2][4][2];
        { f32x4 cs[2][2];
#pragma unroll
          for (int bj = 0; bj < 2; ++bj)
#pragma unroll
              for (int n = 0; n < 2; ++n) { const u32x4 a = P.cm[bj][n];
#pragma unroll
                  for (int e = 0; e < 4; ++e) cs[bj][n][e] = __uint_as_float(a[e]) * (pn >= 16 ? -1.4426950408889634f / 127.0f : 1.0f / 127.0f); }
#pragma unroll
          for (int ai = 0; ai < 2; ++ai)
#pragma unroll
              for (int m = 0; m < 4; ++m) { const float rs = P.rs[ai][m];
#pragma unroll
                  for (int bj = 0; bj < 2; ++bj)
#pragma unroll
                      for (int n = 0; n < 2; ++n)
#pragma unroll
                          for (int e = 0; e < 4; ++e) acc[ai][bj][m][n][e] = (float)__float_as_int(acc_in[ai][bj][m][n][e]) * (rs * cs[bj][n][e]); } }
        if (pn >= 12 && pn < 16) {
            const int jj = 4 * (fr >> 3) + (fr & 3), hh = (fr >> 2) & 1;
#pragma unroll
            for (int ai = 0; ai < 2; ++ai)
#pragma unroll
                for (int m = 0; m < 4; ++m) { const int row = row0 + ai * HALF + m * 16, b = row >> 12, kb = (row & 4095) >> 5, s = m & 1;
#pragma unroll
                    for (int bj = 0; bj < 2; ++bj) { const int h = 2 * (pn - 12) + bj;
                        bf16_t* vp = v3 + ((size_t)((((((b * 8 + h) * 128 + kb) * 4 + wc) * 2 + s) * 2 + hh) * 32 + 8 * fq) * 8 + jj);
#pragma unroll
                        for (int n = 0; n < 2; ++n)
#pragma unroll
                            for (int e = 0; e < 4; e += 2) { const unsigned w = cvt_pk_bf16(acc[ai][bj][m][n][e], acc[ai][bj][m][n][e + 1]);
                                vp[(4 * n + e) * 8] = (bf16_t)(w & 0xffffu); vp[(4 * n + e + 1) * 8] = (bf16_t)(w >> 16); } } }
            return;
        }
        if (pn >= 8 && pn < 12) {
#pragma unroll
            for (int ai = 0; ai < 2; ++ai)
#pragma unroll
                for (int m = 0; m < 4; ++m) { const int row = row0 + ai * HALF + m * 16, b = row >> 12, kb = (row & 4095) >> 5, r = row & 31;
#pragma unroll
                    for (int bj = 0; bj < 2; ++bj) { const int h = 2 * (pn - 8) + bj, s = 2 * wc + (fq >> 1), hh = fq & 1;
                        const f32x4 v0 = acc[ai][bj][m][0], v1 = acc[ai][bj][m][1];
                        u32x4 w; w.x = cvt_pk_bf16(v0[0], v0[1]); w.y = cvt_pk_bf16(v0[2], v0[3]); w.z = cvt_pk_bf16(v1[0], v1[1]); w.w = cvt_pk_bf16(v1[2], v1[3]);
                        *(u32x4*)(k2 + ((size_t)(((((b * 8 + h) * 128 + kb) * 8 + s) * 2 + hh) * 32 + r) * 8)) = w; } }
            return;
        }
        bf16_t* base; int ldc, colt; bool sig = false;
        if (pn < 4) { base = upool; ldc = 1024; colt = pn * BM; }
        else if (pn < 8) { base = q; ldc = 1024; colt = (pn - 4) * BM; }
        else { base = gates; ldc = 4096; colt = (pn - 16) * BM; sig = true; }
#pragma unroll
        for (int ai = 0; ai < 2; ++ai)
#pragma unroll
            for (int m = 0; m < 4; ++m) { bf16_t* rowp = base + (size_t)(row0 + ai * HALF + m * 16) * ldc + colt + wc * 32 + 8 * fq;
#pragma unroll
                for (int bj = 0; bj < 2; ++bj) { f32x4 v0 = acc[ai][bj][m][0], v1 = acc[ai][bj][m][1];
                    if (sig) {
#pragma unroll
                        for (int e = 0; e < 4; ++e) { v0[e] = __builtin_amdgcn_rcpf(1.0f + __builtin_amdgcn_exp2f(v0[e])); v1[e] = __builtin_amdgcn_rcpf(1.0f + __builtin_amdgcn_exp2f(v1[e])); } }
                    u32x4 w; w.x = cvt_pk_bf16(v0[0], v0[1]); w.y = cvt_pk_bf16(v0[2], v0[3]); w.z = cvt_pk_bf16(v1[0], v1[1]); w.w = cvt_pk_bf16(v1[2], v1[3]);
                    *(u32x4*)(rowp + bj * HALF) = w; } }
    }
};
struct EpiPool {
    static constexpr bool PERM = true; static constexpr bool PRE = false;
    bf16_t* O; const float* scale;
    __device__ __forceinline__ void operator()(const f32x4 (&acc)[2][2][4][2], const Unit& u, int wr, int wc) const {
        const int lane_ = lane_id_now(); const int fr = lane_ & 15, fq = lane_ >> 4;
        const int row0 = u.pm * BM + wr * 64 + fr, col0 = u.pn * BM + wc * 32 + 8 * fq;
#pragma unroll
        for (int bj = 0; bj < 2; ++bj) { const f32x4 s0 = *(const f32x4*)(scale + col0 + bj * HALF), s1 = *(const f32x4*)(scale + col0 + bj * HALF + 4);
#pragma unroll
            for (int ai = 0; ai < 2; ++ai)
#pragma unroll
                for (int m = 0; m < 4; ++m) { bf16_t* rowp = O + (size_t)(row0 + ai * HALF + m * 16) * 1024 + col0;
                    const f32x4 v0 = acc[ai][bj][m][0] * s0, v1 = acc[ai][bj][m][1] * s1;
                    u32x4 w; w.x = cvt_pk_bf16(v0[0], v0[1]); w.y = cvt_pk_bf16(v0[2], v0[3]); w.z = cvt_pk_bf16(v1[0], v1[1]); w.w = cvt_pk_bf16(v1[2], v1[3]);
                    *(u32x4*)(rowp + bj * HALF) = w; }
            asm volatile("" ::: "memory"); }
    }
};
template <int STEP> struct EpiGate {
    static constexpr bool PERM = true; static constexpr bool PRE = false;
    const bf16_t* gates; bf16_t* T; bf16_t* O;
    __device__ __forceinline__ void operator()(const f32x4 (&acc)[2][2][4][2], const Unit& u, int wr, int wc) const {
        const int lane_ = lane_id_now(); const int fr = lane_ & 15, fq = lane_ >> 4;
        const int row0 = u.pm * BM + wr * 64 + fr, col0 = u.pn * BM + wc * 32 + 8 * fq;
#pragma unroll
        for (int ai = 0; ai < 2; ++ai) {
            u32x4 gv[4][2], tv[4][2];
#pragma unroll
            for (int m = 0; m < 4; ++m)
#pragma unroll
                for (int bj = 0; bj < 2; ++bj) { const size_t row = (size_t)(row0 + ai * HALF + m * 16); const int col = col0 + bj * HALF;
                    gv[m][bj] = *(const u32x4*)(gates + row * 4096 + (STEP == 1 ? 0 : 2048) + col);
                    if (STEP == 2) tv[m][bj] = *(const u32x4*)(T + row * 2048 + col); }
#pragma unroll
            for (int m = 0; m < 4; ++m)
#pragma unroll
                for (int bj = 0; bj < 2; ++bj) { const size_t row = (size_t)(row0 + ai * HALF + m * 16); const int col = col0 + bj * HALF;
                    const u32x4 g = gv[m][bj];
                    f32x4 v0 = acc[ai][bj][m][0], v1 = acc[ai][bj][m][1];
                    v0[0] *= bf_lo(g.x); v0[1] *= bf_hi(g.x); v0[2] *= bf_lo(g.y); v0[3] *= bf_hi(g.y); v1[0] *= bf_lo(g.z); v1[1] *= bf_hi(g.z); v1[2] *= bf_lo(g.w); v1[3] *= bf_hi(g.w);
                    if (STEP == 2) { const u32x4 t = tv[m][bj];
                        v0[0] += bf_lo(t.x); v0[1] += bf_hi(t.x); v0[2] += bf_lo(t.y); v0[3] += bf_hi(t.y); v1[0] += bf_lo(t.z); v1[1] += bf_hi(t.z); v1[2] += bf_lo(t.w); v1[3] += bf_hi(t.w); }
                    u32x4 w; w.x = cvt_pk_bf16(v0[0], v0[1]); w.y = cvt_pk_bf16(v0[2], v0[3]); w.z = cvt_pk_bf16(v1[0], v1[1]); w.w = cvt_pk_bf16(v1[2], v1[3]);
                    *(u32x4*)((STEP == 1 ? T : O) + row * 2048 + col) = w; }
            asm volatile("" ::: "memory");
        }
    }
};
struct EpiResid {
    static constexpr bool PERM = false; static constexpr bool PRE = false;
    const float* base; float* out;
    __device__ __forceinline__ void operator()(const f32x4 (&acc)[2][2][4][2], const Unit& u, int wr, int wc) const {
        const int lane_ = lane_id_now(); const int fr = lane_ & 15, fq = lane_ >> 4;
        const int row0 = u.pm * BM + wr * 64 + fr, col0 = u.pn * BM + wc * 32 + 4 * fq;
#pragma unroll
        for (int ai = 0; ai < 2; ++ai)
#pragma unroll
            for (int mp = 0; mp < 2; ++mp) {
                f32x4 bv[2][2][2];
#pragma unroll
                for (int mm = 0; mm < 2; ++mm) { const size_t off = (size_t)(row0 + ai * HALF + (2 * mp + mm) * 16) * 2048 + col0;
#pragma unroll
                    for (int bj = 0; bj < 2; ++bj)
#pragma unroll
                        for (int n = 0; n < 2; ++n) bv[mm][bj][n] = base ? *(const f32x4*)(base + off + bj * HALF + n * 16) : (f32x4){0.f, 0.f, 0.f, 0.f}; }
#pragma unroll
                for (int mm = 0; mm < 2; ++mm) { const size_t off = (size_t)(row0 + ai * HALF + (2 * mp + mm) * 16) * 2048 + col0;
#pragma unroll
                    for (int bj = 0; bj < 2; ++bj)
#pragma unroll
                        for (int n = 0; n < 2; ++n) *(f32x4*)(out + off + bj * HALF + n * 16) = acc[ai][bj][2 * mp + mm][n] + bv[mm][bj][n]; }
                asm volatile("" ::: "memory");
            }
    }
};
struct EpiPart {
    static constexpr bool PERM = true; static constexpr bool PRE = false;
    bf16_t* y0; bf16_t* y1; float sc;
    __device__ __forceinline__ void operator()(const f32x4 (&acc)[2][2][4][2], const Unit& u, int wr, int wc) const {
        const int lane_ = lane_id_now(); const int fr = lane_ & 15, fq = lane_ >> 4;
        bf16_t* out = u.part ? y1 + (size_t)(u.part - 1) * 65536 : y0; const int ldc = u.part ? 256 : 2048;
        const int row0 = (u.part ? 0 : u.pm * BM) + wr * 64 + fr, col0 = (u.part ? 0 : u.pn * BM) + wc * 32 + 8 * fq;
#pragma unroll
        for (int ai = 0; ai < 2; ++ai)
#pragma unroll
            for (int m = 0; m < 4; ++m) { bf16_t* rowp = out + (size_t)(row0 + ai * HALF + m * 16) * ldc + col0;
#pragma unroll
                for (int bj = 0; bj < 2; ++bj) { const f32x4 v0 = acc[ai][bj][m][0] * sc, v1 = acc[ai][bj][m][1] * sc;
                    u32x4 w; w.x = cvt_pk_bf16(v0[0], v0[1]); w.y = cvt_pk_bf16(v0[2], v0[3]); w.z = cvt_pk_bf16(v1[0], v1[1]); w.w = cvt_pk_bf16(v1[2], v1[3]);
                    *(u32x4*)(rowp + bj * HALF) = w; } }
    }
};
__device__ __forceinline__ unsigned pk4_fp8(float a, float b, float c, float d) {
    float hi = 448.f; asm volatile("" : "+s"(hi));
    a = __builtin_amdgcn_fmed3f(a, -hi, hi); b = __builtin_amdgcn_fmed3f(b, -hi, hi); c = __builtin_amdgcn_fmed3f(c, -hi, hi); d = __builtin_amdgcn_fmed3f(d, -hi, hi);
    int w = 0; w = __builtin_amdgcn_cvt_pk_fp8_f32(a, b, w, false); w = __builtin_amdgcn_cvt_pk_fp8_f32(c, d, w, true); return (unsigned)w;
}
constexpr float FP8_W_SCALE = 128.f, FP8_H_SCALE = 8.f, FP8_G_SCALE = 4.f;
struct EpiSwiGLU8 {
    static constexpr bool PERM = true; static constexpr bool PRE = false;
    unsigned char* G;
    __device__ __forceinline__ void operator()(const f32x4 (&acc)[2][2][4][2], const Unit& u, int wr, int wc) const {
        const int lane_ = lane_id_now(); const int fr = lane_ & 15, fq = lane_ >> 4;
        const int row0 = u.pm * BM + wr * 64 + fr, col0 = u.pn * HALF + wc * 32 + 8 * fq;
        constexpr float inv = 1.0f / (FP8_W_SCALE * FP8_H_SCALE), k1 = -1.4426950408889634f * inv, k2 = inv * inv * FP8_G_SCALE;
#pragma unroll
        for (int ai = 0; ai < 2; ++ai)
#pragma unroll
            for (int m = 0; m < 4; ++m) { unsigned char* rowp = G + (size_t)(row0 + ai * HALF + m * 16) * 5632 + col0;
                f32x4 v[2];
#pragma unroll
                for (int n = 0; n < 2; ++n)
#pragma unroll
                    for (int e = 0; e < 4; ++e) { const float ag = acc[ai][0][m][n][e], au = acc[ai][1][m][n][e];
                        v[n][e] = (ag * au) * (__builtin_amdgcn_rcpf(1.0f + __builtin_amdgcn_exp2f(ag * k1)) * k2); }
                u32x2 w; w.x = pk4_fp8(v[0][0], v[0][1], v[0][2], v[0][3]); w.y = pk4_fp8(v[1][0], v[1][1], v[1][2], v[1][3]);
                *(u32x2*)rowp = w; }
    }
};
struct EpiSwiGLUi8 {
    static constexpr bool PERM = true; static constexpr bool PRE = true;
    bf16_t* G; const float* rowscale; const unsigned* colmax;
    struct Pre { u32x4 cm[2][2]; float rs[2][4]; };
    __device__ __forceinline__ void pre(const Unit& u, int wr, int wc, Pre& P) const {
        const int lane_ = lane_id_now(); const int fr = lane_ & 15, fq = lane_ >> 4; const int col0 = u.pn * HALF + wc * 32 + 8 * fq;
#pragma unroll
        for (int n = 0; n < 2; ++n) { P.cm[0][n] = *(const u32x4*)(colmax + col0 + 4 * n); P.cm[1][n] = *(const u32x4*)(colmax + 5632 + col0 + 4 * n); }
#pragma unroll
        for (int ai = 0; ai < 2; ++ai)
#pragma unroll
            for (int m = 0; m < 4; ++m) P.rs[ai][m] = rowscale[u.pm * BM + wr * 64 + fr + ai * HALF + m * 16];
    }
    __device__ __forceinline__ void operator()(const f32x4 (&acc)[2][2][4][2], const Unit& u, int wr, int wc, const Pre& P) const {
        const int lane_ = lane_id_now(); const int fr = lane_ & 15, fq = lane_ >> 4;
        const int row0 = u.pm * BM + wr * 64 + fr, col0 = u.pn * HALF + wc * 32 + 8 * fq;
        f32x4 cg[2], cu[2];
#pragma unroll
        for (int n = 0; n < 2; ++n) { const u32x4 a = P.cm[0][n], b = P.cm[1][n];
#pragma unroll
            for (int e = 0; e < 4; ++e) { cg[n][e] = __uint_as_float(a[e]) * (1.0f / 127.0f); cu[n][e] = __uint_as_float(b[e]) * (1.0f / 127.0f); } }
#pragma unroll
        for (int ai = 0; ai < 2; ++ai)
#pragma unroll
            for (int m = 0; m < 4; ++m) { const int row = row0 + ai * HALF + m * 16; const float rs = P.rs[ai][m]; bf16_t* rowp = G + (size_t)row * 5632 + col0;
                f32x4 v[2];
#pragma unroll
                for (int n = 0; n < 2; ++n)
#pragma unroll
                    for (int e = 0; e < 4; ++e) { const float g = (float)__float_as_int(acc[ai][0][m][n][e]) * (rs * cg[n][e]), up = (float)__float_as_int(acc[ai][1][m][n][e]) * (rs * cu[n][e]); v[n][e] = g * sigmoidf_(g) * up; }
                u32x4 w; w.x = cvt_pk_bf16(v[0][0], v[0][1]); w.y = cvt_pk_bf16(v[0][2], v[0][3]); w.z = cvt_pk_bf16(v[1][0], v[1][1]); w.w = cvt_pk_bf16(v[1][2], v[1][3]);
                *(u32x4*)rowp = w; }
    }
};
struct EpiSwiGLU {
    static constexpr bool PERM = true; static constexpr bool PRE = false;
    bf16_t* G;
    __device__ __forceinline__ void operator()(const f32x4 (&acc)[2][2][4][2], const Unit& u, int wr, int wc) const {
        const int lane_ = lane_id_now(); const int fr = lane_ & 15, fq = lane_ >> 4;
        const int row0 = u.pm * BM + wr * 64 + fr, col0 = u.pn * HALF + wc * 32 + 8 * fq;
#pragma unroll
        for (int ai = 0; ai < 2; ++ai)
#pragma unroll
            for (int m = 0; m < 4; ++m) { bf16_t* rowp = G + (size_t)(row0 + ai * HALF + m * 16) * 5632 + col0;
                f32x4 v[2];
#pragma unroll
                for (int n = 0; n < 2; ++n)
#pragma unroll
                    for (int e = 0; e < 4; ++e) { const float g = acc[ai][0][m][n][e], up = acc[ai][1][m][n][e]; v[n][e] = g * sigmoidf_(g) * up; }
                u32x4 w; w.x = cvt_pk_bf16(v[0][0], v[0][1]); w.y = cvt_pk_bf16(v[0][2], v[0][3]); w.z = cvt_pk_bf16(v[1][0], v[1][1]); w.w = cvt_pk_bf16(v[1][2], v[1][3]);
                *(u32x4*)rowp = w; }
    }
};

struct NoHook { static constexpr bool ON = false; struct Regs {}; };
template <class E, bool P = E::PRE> struct PreOf { struct type {}; };
template <class E> struct PreOf<E, true> { using type = typename E::Pre; };
template <int LDA, int LDB, int KDIM, class Epi, class Sched, bool ALIGN_EPI = true, bool VARK = false, int FP8 = 0  , bool GATH = false  , class Hook = NoHook  >
__device__ __forceinline__ void gemm_phase(PG8_LAS unsigned char* lds, const bf16_t* gA, const bf16_t* gBt, const Sched& S, const Epi& E, int wid_in, const Hook& HK = Hook()) {
    const int lane = lane_id_now();
    const int wid = wid_in, tid = wid * 64 + lane, wr = wid >> 2, wc = wid & 3, fr = lane & 15, fq = lane >> 4;
    constexpr int nt = KDIM / BK;
    unsigned voffA[2], voffB[2];
#pragma unroll
    for (int i = 0; i < 2; ++i) { int R, C; stage_rc(tid * 16 + i * 8192, R, C); const int Rb = Epi::PERM ? ((R & ~31) + perm32(R & 31)) : R;
        voffA[i] = (unsigned)(R * LDA + C) * 2u; voffB[i] = (unsigned)(Rb * LDB + C) * 2u; }
    constexpr size_t kstep = (size_t)(BK * 2);
    constexpr size_t hstepA = (size_t)HALF * LDA * 2, hstepB = (size_t)HALF * LDB * 2;
    const unsigned ldsw = (unsigned)wid * 1024u, ldsb = (unsigned)(size_t)lds;
    const int aoff = lds_byte(wr * 64 + fr, fq * 8), boff = lds_byte(wc * 32 + fr, fq * 8);
#define PG8_SA(b, h) (((b) * 2 + (h)) * HTB)
#define PG8_SB(b, h) ((4 + (b) * 2 + (h)) * HTB)
#define PG8_STAGE(bufoff, gbase, voff) do { _Pragma("unroll") for (int _i = 0; _i < 2; ++_i) { unsigned _keep; \
        asm volatile("s_mov_b32 %0, m0\n\ts_mov_b32 m0, %3\n\ts_nop 0\n\tglobal_load_lds_dwordx4 %1, %2\n\ts_mov_b32 m0, %0" : "=&s"(_keep) : "v"((voff)[_i]), "s"((const char*)(gbase)), "s"(ldsb + (unsigned)(bufoff) + ldsw + (unsigned)(_i * 8192)) : "memory"); } } while (0)
#define PG8_LDA(dst, b, h) do { _Pragma("unroll") for (int m = 0; m < 4; ++m) _Pragma("unroll") for (int k = 0; k < 2; ++k) dst[m][k] = *(const PG8_LAS bf16x8*)(lds + PG8_SA(b, h) + aoff + m * 2048 + k * 1024); } while (0)
#define PG8_LDB(dst, b, h) do { _Pragma("unroll") for (int n = 0; n < 2; ++n) _Pragma("unroll") for (int k = 0; k < 2; ++k) dst[n][k] = *(const PG8_LAS bf16x8*)(lds + PG8_SB(b, h) + boff + n * 2048 + k * 1024); } while (0)
#define PG8_MMA(ai, bj, At, Bt) do { __builtin_amdgcn_s_setprio(1); _Pragma("unroll") for (int m = 0; m < 4; ++m) _Pragma("unroll") for (int n = 0; n < 2; ++n) { \
        if constexpr (FP8 == 2) { _Pragma("unroll") for (int k = 0; k < 2; ++k) acc[ai][bj][m][n] = __builtin_bit_cast(f32x4, __builtin_amdgcn_mfma_i32_16x16x64_i8(__builtin_bit_cast(i32x4, Bt[n][k]), __builtin_bit_cast(i32x4, At[m][k]), __builtin_bit_cast(i32x4, acc[ai][bj][m][n]), 0, 0, 0)); } \
        else if constexpr (FP8 == 1) { const i32x8 b8 = __builtin_shufflevector(__builtin_bit_cast(i32x4, Bt[n][0]), __builtin_bit_cast(i32x4, Bt[n][1]), 0, 1, 2, 3, 4, 5, 6, 7), a8 = __builtin_shufflevector(__builtin_bit_cast(i32x4, At[m][0]), __builtin_bit_cast(i32x4, At[m][1]), 0, 1, 2, 3, 4, 5, 6, 7); \
            acc[ai][bj][m][n] = __builtin_amdgcn_mfma_scale_f32_16x16x128_f8f6f4(b8, a8, acc[ai][bj][m][n], 0, 0, 0, 0x7F7F7F7F, 0, 0x7F7F7F7F); } \
        else { _Pragma("unroll") for (int k = 0; k < 2; ++k) acc[ai][bj][m][n] = __builtin_amdgcn_mfma_f32_16x16x32_bf16(Bt[n][k], At[m][k], acc[ai][bj][m][n], 0, 0, 0); } } \
        __builtin_amdgcn_s_setprio(0); } while (0)
#define PG8_WAIT_V(n) asm volatile("s_waitcnt vmcnt(" #n ")" ::: "memory")
#define PG8_WAIT_L(n) asm volatile("s_waitcnt lgkmcnt(" #n ")" ::: "memory")
#define PG8_BAR __builtin_amdgcn_s_barrier()
#define PG8_SCHED __builtin_amdgcn_sched_barrier(0)
    Unit cur, nxt; int ui = 0;
    if (!S.next(0, cur)) return;
    typename PreOf<Epi>::type pf;
    f32x4 acc[2][2][4][2];
#pragma unroll
    for (int a = 0; a < 2; ++a)
#pragma unroll
        for (int b = 0; b < 2; ++b)
#pragma unroll
            for (int m = 0; m < 4; ++m)
#pragma unroll
                for (int n = 0; n < 2; ++n) asm volatile("" : "=v"(acc[a][b][m][n]));
    bf16x8 At[4][2], B0[2][2], B1[2][2];
    const char* cA = (const char*)gA + (GATH ? (size_t)0 : cur.aoff); const char* cB = (const char*)gBt + cur.boff;
    constexpr size_t hA = GATH ? (size_t)0 : hstepA;
    unsigned gi0[2] = {0u, 0u}, gi1[2] = {0u, 0u}, ni0[2] = {0u, 0u}, ni1[2] = {0u, 0u}, gRow4[2] = {0u, 0u}, gC2[2] = {0u, 0u};
#define PG8_LDIDX(dst, idx) asm volatile("global_load_dword %0, %1, %2" : "=v"(dst) : "v"((unsigned)(idx)), "s"(S_inv) : "memory")
    const int* S_inv = nullptr;
    if constexpr (GATH) { S_inv = S.inv;
#pragma unroll
        for (int i = 0; i < 2; ++i) { int R, C; stage_rc(tid * 16 + i * 8192, R, C); gRow4[i] = (unsigned)R * 4u; gC2[i] = (unsigned)C * 2u;
            PG8_LDIDX(gi0[i], (unsigned)cur.gbase * 4u + gRow4[i]); PG8_LDIDX(gi1[i], (unsigned)cur.gbase * 4u + 512u + gRow4[i]); }
        asm volatile("s_waitcnt vmcnt(0)" ::: "memory");
#pragma unroll
        for (int i = 0; i < 2; ++i) { asm volatile("" : "+v"(gi0[i]), "+v"(gi1[i])); }
    }
    unsigned va0[2], va1[2];
#pragma unroll
    for (int i = 0; i < 2; ++i) { va0[i] = GATH ? gi0[i] * (unsigned)(LDA * 2) + gC2[i] : voffA[i]; va1[i] = GATH ? gi1[i] * (unsigned)(LDA * 2) + gC2[i] : voffA[i]; }
    PG8_STAGE(PG8_SB(0, 0), cB, voffB); PG8_STAGE(PG8_SB(0, 1), cB + hstepB, voffB); PG8_STAGE(PG8_SA(0, 0), cA, va0); PG8_STAGE(PG8_SA(0, 1), cA + hA, va1);
    if (wr == 1) PG8_BAR;
    PG8_WAIT_V(2); PG8_BAR;
    PG8_STAGE(PG8_SB(1, 0), cB + kstep, voffB); PG8_STAGE(PG8_SA(1, 0), cA + kstep, va0); PG8_STAGE(PG8_SB(1, 1), cB + hstepB + kstep, voffB);
    PG8_WAIT_V(6); PG8_BAR;
    for (;;) {
        const bool has_next = S.next(ui + 1, nxt);
        const char* nA = (has_next && !GATH) ? (const char*)gA + nxt.aoff : cA; const char* nB = has_next ? (const char*)gBt + nxt.boff : cB;
        if constexpr (GATH) { if (has_next) {
#pragma unroll
            for (int i = 0; i < 2; ++i) { PG8_LDIDX(ni0[i], (unsigned)nxt.gbase * 4u + gRow4[i]); PG8_LDIDX(ni1[i], (unsigned)nxt.gbase * 4u + 512u + gRow4[i]); } } }
        const int ntu = VARK ? cur.nkt : nt;
#pragma nounroll
        for (int t = 0; t < ntu; t += 2) {
            const bool last = (t == ntu - 2);
            const char* a1 = cA + (size_t)(t + 1) * kstep;
            const char* a2 = last ? nA : cA + (size_t)(t + 2) * kstep; const char* b2 = last ? nB : cB + (size_t)(t + 2) * kstep;
            const char* a3 = a2 + kstep; const char* b3 = b2 + kstep;
            unsigned sel0[2], sel1[2];
#pragma unroll
            for (int i = 0; i < 2; ++i) {
                if constexpr (GATH) { unsigned x0 = ni0[i], x1 = ni1[i]; asm volatile("" : "+v"(x0), "+v"(x1));
                    sel0[i] = last ? x0 * (unsigned)(LDA * 2) + gC2[i] : va0[i]; sel1[i] = last ? x1 * (unsigned)(LDA * 2) + gC2[i] : va1[i]; }
                else { sel0[i] = voffA[i]; sel1[i] = voffA[i]; } }
            PG8_LDB(B0, 0, 0); PG8_LDB(B1, 0, 1); PG8_SCHED; PG8_LDA(At, 0, 0); PG8_STAGE(PG8_SA(1, 1), a1 + hA, va1);
            if (t == 0) {
#pragma unroll
                for (int a = 0; a < 2; ++a)
#pragma unroll
                    for (int b = 0; b < 2; ++b)
#pragma unroll
                        for (int m = 0; m < 4; ++m)
#pragma unroll
                            for (int n = 0; n < 2; ++n) acc[a][b][m][n] = (f32x4){0.f, 0.f, 0.f, 0.f};
            }
            PG8_SCHED;
            PG8_WAIT_V(8); PG8_WAIT_L(0); PG8_BAR; PG8_MMA(0, 0, At, B0); PG8_MMA(0, 1, At, B1); PG8_BAR; PG8_SCHED;
            PG8_LDA(At, 0, 1); PG8_STAGE(PG8_SB(0, 0), b2, voffB); PG8_STAGE(PG8_SB(0, 1), b2 + hstepB, voffB); PG8_STAGE(PG8_SA(0, 0), a2, sel0);
            PG8_WAIT_V(8); PG8_WAIT_L(0); PG8_BAR; PG8_MMA(1, 0, At, B0); PG8_MMA(1, 1, At, B1); PG8_BAR; PG8_SCHED;
            PG8_LDB(B0, 1, 0); PG8_LDB(B1, 1, 1); PG8_SCHED; PG8_LDA(At, 1, 0); PG8_STAGE(PG8_SA(0, 1), a2 + hA, sel1);
            PG8_WAIT_V(8); PG8_WAIT_L(0); PG8_BAR; PG8_MMA(0, 0, At, B0); PG8_MMA(0, 1, At, B1); PG8_BAR; PG8_SCHED;
            PG8_LDA(At, 1, 1); PG8_STAGE(PG8_SB(1, 0), b3, voffB); PG8_STAGE(PG8_SB(1, 1), b3 + hstepB, voffB); PG8_STAGE(PG8_SA(1, 0), a3, sel0);
            PG8_WAIT_V(8); PG8_WAIT_L(0); PG8_BAR; PG8_MMA(1, 0, At, B0); PG8_MMA(1, 1, At, B1); PG8_BAR; PG8_SCHED;
        }
        if constexpr (ALIGN_EPI) { if (wr == 0) PG8_BAR; }
        typename Hook::Regs hkr;
        if constexpr (Epi::PRE) { E.pre(cur, wr, wc, pf); asm volatile("" ::: "memory"); }
        if constexpr (Hook::ON) HK.issue(ui * S.G + S.c, wid, hkr);
        if constexpr (Epi::PRE) E(acc, cur, wr, wc, pf); else E(acc, cur, wr, wc);
        if constexpr (Hook::ON) HK.finish(wid, hkr);
        if (!has_next) break;
#pragma unroll
        for (int a = 0; a < 2; ++a)
#pragma unroll
            for (int b = 0; b < 2; ++b)
#pragma unroll
                for (int m = 0; m < 4; ++m)
#pragma unroll
                    for (int n = 0; n < 2; ++n) asm volatile("" : "=v"(acc[a][b][m][n]));
        cur = nxt; cA = nA; cB = nB; ++ui;
        if constexpr (GATH) {
#pragma unroll
            for (int i = 0; i < 2; ++i) { gi0[i] = ni0[i]; gi1[i] = ni1[i]; va0[i] = gi0[i] * (unsigned)(LDA * 2) + gC2[i]; va1[i] = gi1[i] * (unsigned)(LDA * 2) + gC2[i]; } }
        if constexpr (ALIGN_EPI) { if (wr == 1) PG8_BAR; }
    }
    PG8_WAIT_V(0);
    if constexpr (!ALIGN_EPI) { if (wr == 0) PG8_BAR; }
    PG8_BAR;
#undef PG8_SA
#undef PG8_SB
#undef PG8_STAGE
#undef PG8_LDIDX
#undef PG8_LDA
#undef PG8_LDB
#undef PG8_MMA
#undef PG8_WAIT_V
#undef PG8_WAIT_L
#undef PG8_BAR
#undef PG8_SCHED
}
}

constexpr int NWAVES = 8;
constexpr int SEQ = 4096, M = 8192, D = 2048, DFF = 5632, NE = 8, INC = 8192, PW = 1024;
constexpr float RMS_EPS = 1e-6f;
constexpr int MOE_MAX_TILES = 72;
constexpr int MOE_DOWN_KSPLIT = 1;
constexpr size_t MiB = 1u << 20;
constexpr size_t WS_CTL = 0, CTL_ZERO_BYTES = 1 * MiB;
constexpr size_t WS_TOK = 1 * MiB;
constexpr size_t WS_WIN = 2 * MiB;
constexpr size_t WS_POOLW = 66 * MiB;
constexpr size_t WS_WPU = 67 * MiB;
constexpr size_t WS_WAU = 75 * MiB;
constexpr size_t WS_WOUT = 83 * MiB;
constexpr size_t WS_FGU = 99 * MiB;
constexpr size_t WS_FD = 143 * MiB;
constexpr size_t WS_MGU = 165 * MiB;
constexpr size_t WS_MD = 517 * MiB;
constexpr size_t WS_X = 693 * MiB;
constexpr size_t WS_H = 757 * MiB;
constexpr size_t WS_MIX = 789 * MiB;
constexpr size_t WS_UPOOL = WS_MIX, WS_Q = WS_MIX + 16 * MiB, WS_K = WS_MIX + 32 * MiB, WS_VT = WS_MIX + 48 * MiB, WS_GATES = WS_MIX + 64 * MiB,
                 WS_POOLED = WS_MIX + 128 * MiB, WS_YPOOL = WS_MIX + 144 * MiB, WS_YATTN = WS_MIX + 160 * MiB, WS_T = WS_MIX + 176 * MiB, WS_MERGED = WS_MIX + 208 * MiB;
constexpr size_t WS_G = WS_MIX;
constexpr size_t WS_HS = 1029 * MiB;
constexpr size_t WS_Y = 1101 * MiB;
constexpr size_t WS_Y2 = 1173 * MiB;
constexpr size_t WS_END = 1245 * MiB;
static_assert((size_t)MOE_MAX_TILES * 256 * DFF * 2 <= 240 * MiB, "G overlay");
constexpr int CW_BAR = 4096;
constexpr int CW_ECNT = 8192;
constexpr int CW_COLMAX = 32768;
constexpr int CW_COLMAX_WIN = 49152;
constexpr int CW_INV = 131072;
constexpr int CW_KPART = 16384;
constexpr int RING_OFF = 0, RING_BYTES = 131072;
constexpr int LDSCTL_OFF = RING_BYTES, MISC_OFF = LDSCTL_OFF + 320;
constexpr int LDS_BYTES = 147456;

#define GAS __attribute__((address_space(1)))
#define LAS __attribute__((address_space(3)))
typedef unsigned short bf16;
typedef unsigned v4u __attribute__((ext_vector_type(4)));
typedef unsigned v2u __attribute__((ext_vector_type(2)));
typedef float f32x4 __attribute__((ext_vector_type(4)));
typedef float f32x2 __attribute__((ext_vector_type(2)));
typedef float f32x16 __attribute__((ext_vector_type(16)));
typedef unsigned u32x2_t __attribute__((ext_vector_type(2)));
typedef short bf16x8 __attribute__((ext_vector_type(8)));
typedef short s16x4 __attribute__((ext_vector_type(4)));
typedef __bf16 bf2_t __attribute__((ext_vector_type(2)));
typedef GAS unsigned gu32;
#define RLX_AGENT __ATOMIC_RELAXED, __HIP_MEMORY_SCOPE_AGENT
__device__ __forceinline__ unsigned pk2(float lo, float hi) { f32x2 v = {lo, hi}; return __builtin_bit_cast(unsigned, __builtin_convertvector(v, bf2_t)); }
__device__ __forceinline__ float bflo(unsigned w) { return __uint_as_float(w << 16); }
__device__ __forceinline__ float bfhi(unsigned w) { return __uint_as_float(w & 0xffff0000u); }
template <int K> __device__ __forceinline__ float xor_lt32(float v) { return __int_as_float(__builtin_amdgcn_ds_swizzle(__float_as_int(v), (K << 10) | 0x1F)); }
__device__ __forceinline__ float half_sum(float v) { const auto p = __builtin_amdgcn_permlane32_swap(__float_as_uint(v), __float_as_uint(v), false, false); return __uint_as_float(p[0]) + __uint_as_float(p[1]); }
__device__ __forceinline__ float other_half(float v, int hh) { const auto p = __builtin_amdgcn_permlane32_swap(__float_as_uint(v), __float_as_uint(v), false, false); return __uint_as_float(hh ? p[0] : p[1]); }
__device__ __forceinline__ float wave_sum(float v) {
    v += xor_lt32<1>(v); v += xor_lt32<2>(v); v += xor_lt32<4>(v); v += xor_lt32<8>(v); v += xor_lt32<16>(v);
    return half_sum(v);
}

#define XB_TMO      128
#define XB_XCNT(j)  (256  + 64 * (j))
#define XB_XSUB(j)  (1280 + 64 * (j))
#define XB_XGEN(j)  (2304 + 64 * (j))
#define XB_TOP      3328
#define XB_TOPGEN   3392
#define XCD_BAR_WORDS 3456
#define XB_SPIN_CAP (1u << 18)
__device__ __forceinline__ unsigned xb_ld(unsigned* p)              { return __hip_atomic_load(p, __ATOMIC_RELAXED, __HIP_MEMORY_SCOPE_AGENT); }
__device__ __forceinline__ unsigned xb_add(unsigned* p, unsigned v) { return __hip_atomic_fetch_add(p, v, __ATOMIC_RELAXED, __HIP_MEMORY_SCOPE_AGENT); }
__device__ __forceinline__ unsigned xb_xcc_id() { return (unsigned)__builtin_amdgcn_s_getreg((3 << 11) | 20) & 0xFu; }
#define XB_SPIN(cond, bar) do { unsigned _sp = 0; while (cond) { __builtin_amdgcn_s_sleep(1); \
    if ((++_sp & 255u) == 0u) { if (xb_ld(&(bar)[XB_TMO])) break; if (_sp > XB_SPIN_CAP) { atomicAdd(&(bar)[XB_TMO], 1u); break; } } } } while (0)
struct XcdBarrier { unsigned* bar; unsigned x; volatile LAS unsigned* st; };
__device__ __forceinline__ XcdBarrier xcd_barrier_post(unsigned* bar, volatile LAS unsigned* st) {
    XcdBarrier b; b.bar = bar; b.x = xb_xcc_id(); b.st = st;
    if (threadIdx.x == 0) (void)xb_add(&bar[XB_XCNT(b.x)], 1u);
    return b;
}
__device__ __forceinline__ void xcd_barrier_complete(unsigned* bar, unsigned x, unsigned& nloc, unsigned& nx) {
    const unsigned G = gridDim.x * gridDim.y * gridDim.z;
    unsigned sum, cnt, mine, sp = 0u;
    for (;;) {
        sum = 0u; cnt = 0u; mine = 0u;
#pragma unroll
        for (unsigned j = 0; j < 16; ++j) { const unsigned c = xb_ld(&bar[XB_XCNT(j)]); sum += c; cnt += (c > 0u) ? 1u : 0u; mine = (j == x) ? c : mine; }
        if (sum == G) break;
        __builtin_amdgcn_s_sleep(1);
        if ((++sp & 255u) == 0u) { if (xb_ld(&bar[XB_TMO])) break; if (sp > XB_SPIN_CAP) { atomicAdd(&bar[XB_TMO], 1u); break; } }
    }
    nloc = mine > 0u ? mine : 1u; nx = cnt > 0u ? cnt : 1u;
}
__device__ __forceinline__ void xcd_barrier(const XcdBarrier& b) {
    asm volatile("s_waitcnt vmcnt(0)" ::: "memory");
    __syncthreads();
    if (threadIdx.x == 0) {
        unsigned* bar = b.bar; asm volatile("" : "+s"(bar));
        __builtin_amdgcn_s_waitcnt(0);
        unsigned nloc = b.st[0], nx = b.st[1];
        if (nloc == 0u) { xcd_barrier_complete(bar, b.x, nloc, nx); b.st[0] = nloc; b.st[1] = nx; }
        const unsigned old = xb_add(&bar[XB_XSUB(b.x)], 1u);
        const unsigned gen = old / nloc;
        if (old + 1u == (gen + 1u) * nloc) {
            __builtin_amdgcn_fence(__ATOMIC_RELEASE, "agent");
            asm volatile("s_waitcnt vmcnt(0)" ::: "memory");
            const unsigned og = xb_add(&bar[XB_TOP], 1u);
            const unsigned tg = og / nx;
            if (og + 1u == (tg + 1u) * nx) xb_add(&bar[XB_TOPGEN], 1u);
            else XB_SPIN(xb_ld(&bar[XB_TOPGEN]) == tg, bar);
            __builtin_amdgcn_fence(__ATOMIC_ACQUIRE, "agent");
            xb_add(&bar[XB_XGEN(b.x)], 1u);
            asm volatile("s_waitcnt vmcnt(0)" ::: "memory");
        } else {
            XB_SPIN(xb_ld(&bar[XB_XGEN(b.x)]) == gen, bar);
            __builtin_amdgcn_fence(__ATOMIC_ACQUIRE, "agent");
            asm volatile("s_waitcnt vmcnt(0)" ::: "memory");
        }
    }
    __syncthreads();
}

struct Args { const float* in[17]; float* out; unsigned char* ws; int ph_lo, ph_hi; };
typedef const __attribute__((address_space(4))) Args* ArgsP;
__device__ __forceinline__ ArgsP argp() {
#if defined(__HIP_DEVICE_COMPILE__)
    ArgsP p = (ArgsP)__builtin_amdgcn_kernarg_segment_ptr(); asm volatile("" : "+s"(p)); return p;
#else
    return nullptr;
#endif
}

__device__ __forceinline__ void cvt_load(const float* W, int N, int k0, int n0, int lane, f32x4 (&v)[8]) {
    const float* p = W + (size_t)(k0 + 8 * (lane >> 3)) * N + n0 + 4 * (lane & 7);
#pragma unroll
    for (int it = 0; it < 8; ++it) v[it] = __builtin_nontemporal_load((const f32x4*)(p + (size_t)it * N));
}
__device__ __forceinline__ void cvt_store(bf16* WT, int ldk, int k0, int n0, int rowmode, int lane, const f32x4 (&v)[8]) {
#pragma unroll
    for (int j = 0; j < 4; ++j) { const int n = n0 + 4 * (lane & 7) + j; const int nr = rowmode == 0 ? n : (256 * (n >> 7) + (n & 127) + (rowmode == 2 ? 128 : 0));
        v4u a; a.x = pk2(v[0][j], v[1][j]); a.y = pk2(v[2][j], v[3][j]); a.z = pk2(v[4][j], v[5][j]); a.w = pk2(v[6][j], v[7][j]);
        __builtin_nontemporal_store(a, (v4u*)(WT + (size_t)nr * ldk + k0 + 8 * (lane >> 3))); }
}
struct CvtTile { const float* W; bf16* WT; int N, ldk, k0, n0, mode; const unsigned* cm; };
constexpr int PP_WIN = 32 * 256, PP_FF = 32 * 176;
constexpr int T_WIN = 16 * 256, T_FF8 = 16 * 176;
constexpr int T_PW = 32, T_UP = 16 * 64, T_OUT = 32 * 64, T_FF = 88 * 64;
static_assert((DFF / 128) * (D / 32) == T_FF8, "tile counts");
constexpr int T_LAYER = T_WIN + 4 * T_PW + 2 * T_UP + T_OUT;
constexpr int SEG_A0 = 0, SEG_B0 = T_LAYER, SEG_C0 = SEG_B0 + 2 * T_FF8 + T_FF, SEG_D0 = SEG_C0 + T_LAYER, SEG_E0 = SEG_D0 + 16 * T_FF8, CVT_TILES = SEG_E0 + 8 * T_FF8;
__device__ __forceinline__ void cvt_lookup(ArgsP a, int t, CvtTile& c) {
    unsigned char* ws = a->ws;
    int in = 0; size_t soff = 0, doff = 0; int K = 0, N = 0, mode = 0, cmo = 0;
    if (t < SEG_B0 || (t >= SEG_C0 && t < SEG_D0)) { const int l = t < SEG_B0 ? 0 : 1; int r = t - (l ? SEG_C0 : 0);
        if (r < T_WIN) { in = 2; soff = (size_t)l * D * INC; doff = WS_WIN + (size_t)l * INC * D * 2; K = D; N = INC; t = r; mode = 8; cmo = CW_COLMAX_WIN + l * INC; }
        else if ((r -= T_WIN) < 4 * T_PW) { const int g = r / T_PW; in = 3; soff = (size_t)(l * 4 + g) * 65536; doff = WS_POOLW + (size_t)(l * 4 + g) * 65536 * 2; K = 256; N = 256; t = r % T_PW; }
        else if ((r -= 4 * T_PW) < T_UP) { in = 5; soff = (size_t)l * PW * D; doff = WS_WPU + (size_t)l * D * PW * 2; K = PW; N = D; t = r; }
        else if ((r -= T_UP) < T_UP) { in = 6; soff = (size_t)l * PW * D; doff = WS_WAU + (size_t)l * D * PW * 2; K = PW; N = D; t = r; }
        else { r -= T_UP; in = 7; soff = (size_t)l * D * D; doff = WS_WOUT + (size_t)l * D * D * 2; K = D; N = D; t = r; }
    } else if (t < SEG_C0) { t -= SEG_B0;
        if (t < 2 * T_FF8) { const int w = t / T_FF8; t %= T_FF8; in = 9 + w; doff = WS_FGU; K = D; N = DFF; mode = (1 + w) | 8; cmo = CW_COLMAX + w * DFF; }
        else { t -= 2 * T_FF8; in = 11; doff = WS_FD; K = DFF; N = D; }
    } else if (t < SEG_E0) { t -= SEG_D0; const int e = t / (2 * T_FF8); t %= 2 * T_FF8; const int w = t / T_FF8; t %= T_FF8; in = 13 + w; soff = (size_t)e * D * DFF;
        doff = WS_MGU + (size_t)e * 2 * DFF * D; K = D; N = DFF; mode = (1 + w) | 4;
    } else { t -= SEG_E0; const int e = t / T_FF8; t %= T_FF8; in = 15; soff = (size_t)e * D * DFF; doff = WS_MD + (size_t)e * D * DFF; K = DFF; N = D; mode = 4; }
    const int ntn = N / 32;
    c.W = a->in[in] + soff; c.WT = (bf16*)(ws + doff); c.N = N; c.ldk = K; c.k0 = ((mode & 12) ? 128 : 64) * (t / ntn); c.n0 = 32 * (t % ntn); c.mode = mode; c.cm = (const unsigned*)(ws + WS_CTL) + cmo;
}
__device__ __forceinline__ void cvt_range(ArgsP A, int first, int last, int widx, int nw, int lane) {
    for (int t = first + widx; t < last; t += 4 * nw) {
        CvtTile c0, c1, c2, c3; const int t1 = t + nw, t2 = t + 2 * nw, t3 = t + 3 * nw;
        cvt_lookup(A, t, c0); cvt_lookup(A, t1 < last ? t1 : t, c1); cvt_lookup(A, t2 < last ? t2 : t, c2); cvt_lookup(A, t3 < last ? t3 : t, c3);
        f32x4 va[8], vb[8], vc[8], vd[8];
        cvt_load(c0.W, c0.N, c0.k0, c0.n0, lane, va); cvt_load(c1.W, c1.N, c1.k0, c1.n0, lane, vb); cvt_load(c2.W, c2.N, c2.k0, c2.n0, lane, vc); cvt_load(c3.W, c3.N, c3.k0, c3.n0, lane, vd);
        cvt_store(c0.WT, c0.ldk, c0.k0, c0.n0, c0.mode, lane, va);
        if (t1 < last) cvt_store(c1.WT, c1.ldk, c1.k0, c1.n0, c1.mode, lane, vb);
        if (t2 < last) cvt_store(c2.WT, c2.ldk, c2.k0, c2.n0, c2.mode, lane, vc);
        if (t3 < last) cvt_store(c3.WT, c3.ldk, c3.k0, c3.n0, c3.mode, lane, vd);
    }
}
__device__ __forceinline__ unsigned pk4_i8(float a, float b, float c, float d);
__device__ __forceinline__ void cvt_load_big(const float* W, int N, int k0, int n0, int lane, f32x4 (&v)[16]) {
    const float* p = W + (size_t)(k0 + 16 * (lane >> 3)) * N + n0 + 4 * (lane & 7);
#pragma unroll
    for (int it = 0; it < 16; ++it) v[it] = __builtin_nontemporal_load((const f32x4*)(p + (size_t)it * N));
}
__device__ __forceinline__ void cvt_store_big(const CvtTile& c, int lane, const f32x4 (&v)[16]) {
    const int rowmode = c.mode & 3; v4u cmx = {0u, 0u, 0u, 0u};
    if (c.mode & 8) cmx = *(const v4u*)(c.cm + c.n0 + 4 * (lane & 7));
#pragma unroll
    for (int j = 0; j < 4; ++j) { const int n = c.n0 + 4 * (lane & 7) + j; const int nr = rowmode == 0 ? n : (256 * (n >> 7) + (n & 127) + (rowmode == 2 ? 128 : 0));
        v4u a;
        if (c.mode & 8) { const float mx = __uint_as_float(cmx[j]), s = mx > 0.f ? 127.0f / mx : 0.f;
            a.x = pk4_i8(v[0][j] * s, v[1][j] * s, v[2][j] * s, v[3][j] * s); a.y = pk4_i8(v[4][j] * s, v[5][j] * s, v[6][j] * s, v[7][j] * s);
            a.z = pk4_i8(v[8][j] * s, v[9][j] * s, v[10][j] * s, v[11][j] * s); a.w = pk4_i8(v[12][j] * s, v[13][j] * s, v[14][j] * s, v[15][j] * s); }
        else { const float s = pg8::FP8_W_SCALE;
            a.x = pg8::pk4_fp8(v[0][j] * s, v[1][j] * s, v[2][j] * s, v[3][j] * s); a.y = pg8::pk4_fp8(v[4][j] * s, v[5][j] * s, v[6][j] * s, v[7][j] * s);
            a.z = pg8::pk4_fp8(v[8][j] * s, v[9][j] * s, v[10][j] * s, v[11][j] * s); a.w = pg8::pk4_fp8(v[12][j] * s, v[13][j] * s, v[14][j] * s, v[15][j] * s); }
        __builtin_nontemporal_store(a, (v4u*)((unsigned char*)c.WT + (size_t)nr * c.ldk + c.k0 + 16 * (lane >> 3))); }
}
__device__ __forceinline__ void cvt_range_big(ArgsP A, int first, int last, int widx, int nw, int lane) {
    for (int t = first + widx; t < last; t += 2 * nw) {
        CvtTile c0, c1; const int t1 = t + nw;
        cvt_lookup(A, t, c0); cvt_lookup(A, t1 < last ? t1 : t, c1);
        f32x4 va[16], vb[16];
        cvt_load_big(c0.W, c0.N, c0.k0, c0.n0, lane, va); cvt_load_big(c1.W, c1.N, c1.k0, c1.n0, lane, vb);
        cvt_store_big(c0, lane, va);
        if (t1 < last) cvt_store_big(c1, lane, vb);
    }
}
constexpr int PROJ_CVT = 2048;
constexpr int POOL_CVT = 4096;
template <bool EN> struct CvtHookT {
    static constexpr bool ON = EN;
    int first, last;
    struct Regs { f32x4 v[8]; int t; };
    __device__ __forceinline__ void issue(int L, int wid, Regs& r) const {
        const int t = first + L * HK_TPU + (wid >> 1); r.t = (t < last && (wid >> 1) < HK_TPU) ? t : -1;
        { CvtTile c; cvt_lookup(argp(), r.t >= 0 ? r.t : SEG_D0, c); const int lane = pg8::lane_id_now(); const int Ns = r.t >= 0 ? c.N : 0;
            const float* p = c.W + (size_t)(c.k0 + 16 * (lane >> 3) + 8 * (wid & 1)) * Ns + c.n0 + 4 * (lane & 7);
#pragma unroll
            for (int it = 0; it < 8; ++it) r.v[it] = __builtin_nontemporal_load((const f32x4*)(p + (size_t)it * Ns)); }
    }
    __device__ __forceinline__ void finish(int wid, Regs& r) const {
        if (r.t >= 0) { CvtTile c; cvt_lookup(argp(), r.t, c); const int lane = pg8::lane_id_now(); const int rowmode = c.mode & 3; const float s = pg8::FP8_W_SCALE;
#pragma unroll
            for (int j = 0; j < 4; ++j) { const int n = c.n0 + 4 * (lane & 7) + j; const int nr = rowmode == 0 ? n : (256 * (n >> 7) + (n & 127) + (rowmode == 2 ? 128 : 0));
                pg8::u32x2 a; a.x = pg8::pk4_fp8(r.v[0][j] * s, r.v[1][j] * s, r.v[2][j] * s, r.v[3][j] * s); a.y = pg8::pk4_fp8(r.v[4][j] * s, r.v[5][j] * s, r.v[6][j] * s, r.v[7][j] * s);
                *(pg8::u32x2*)((unsigned char*)c.WT + (size_t)nr * c.ldk + c.k0 + 16 * (lane >> 3) + 8 * (wid & 1)) = a; } }
    }
};
constexpr int CONV_TILES_PER_CU_ROUND_F8 = 32;
constexpr int FGU_G = 240;
constexpr int Q7 = (256 - FGU_G) * 6 * CONV_TILES_PER_CU_ROUND_F8;
constexpr int FGU_CVT = Q7 - (T_LAYER - T_WIN) / 2;
static_assert(FGU_CVT > 0, "conversion quota");
__device__ __forceinline__ float half_max(float v) { const auto p = __builtin_amdgcn_permlane32_swap(__float_as_uint(v), __float_as_uint(v), false, false); return fmaxf(__uint_as_float(p[0]), __uint_as_float(p[1])); }
__device__ __forceinline__ float wave_max(float v) {
    v = fmaxf(v, xor_lt32<1>(v)); v = fmaxf(v, xor_lt32<2>(v)); v = fmaxf(v, xor_lt32<4>(v)); v = fmaxf(v, xor_lt32<8>(v)); v = fmaxf(v, xor_lt32<16>(v));
    return half_max(v);
}
__device__ __forceinline__ void colmax_tile(const float* W, int N, int k0, int n0, int lane, unsigned* cm) {
    f32x4 v[8]; cvt_load(W, N, k0, n0, lane, v);
    f32x4 m = {0.f, 0.f, 0.f, 0.f};
#pragma unroll
    for (int it = 0; it < 8; ++it)
#pragma unroll
        for (int j = 0; j < 4; ++j) m[j] = fmaxf(m[j], fabsf(v[it][j]));
#pragma unroll
    for (int j = 0; j < 4; ++j) { float x = m[j]; x = fmaxf(x, xor_lt32<8>(x)); x = fmaxf(x, xor_lt32<16>(x)); x = half_max(x); m[j] = x; }
    if (lane < 8) {
#pragma unroll
        for (int j = 0; j < 4; ++j) __hip_atomic_fetch_max(cm + n0 + 4 * lane + j, __float_as_uint(m[j]), __ATOMIC_RELAXED, __HIP_MEMORY_SCOPE_AGENT); }
}
__device__ __forceinline__ unsigned pk4_i8(float a, float b, float c, float d) {
    float hi = 127.f; asm volatile("" : "+s"(hi));
    const int ia = (int)__builtin_rintf(__builtin_amdgcn_fmed3f(a, -hi, hi)), ib = (int)__builtin_rintf(__builtin_amdgcn_fmed3f(b, -hi, hi));
    const int ic = (int)__builtin_rintf(__builtin_amdgcn_fmed3f(c, -hi, hi)), id = (int)__builtin_rintf(__builtin_amdgcn_fmed3f(d, -hi, hi));
    return (unsigned)(ia & 0xff) | ((unsigned)(ib & 0xff) << 8) | ((unsigned)(ic & 0xff) << 16) | ((unsigned)(id & 0xff) << 24);
}
constexpr int STRIPS_WIN = INC / 32, STRIPS_FF = DFF / 32, N_STRIPS = 2 * STRIPS_WIN + 2 * STRIPS_FF;
constexpr int HOSTED_HALF = (N_STRIPS - STRIPS_WIN) / 2;
struct StripDesc { const float* W; unsigned char* WT; unsigned* cm; int N, rowmode, n0; };
__device__ __forceinline__ StripDesc strip_lookup(ArgsP A, int sidx) {
    int in, N, rowmode, cmo, n0; size_t soff, doff;
    if (sidx < STRIPS_WIN) { in = 2; N = INC; rowmode = 0; cmo = CW_COLMAX_WIN; soff = 0; doff = WS_WIN; n0 = 32 * sidx; }
    else if (sidx < STRIPS_WIN + STRIPS_FF) { in = 9; N = DFF; rowmode = 1; cmo = CW_COLMAX; soff = 0; doff = WS_FGU; n0 = 32 * (sidx - STRIPS_WIN); }
    else if (sidx < STRIPS_WIN + 2 * STRIPS_FF) { in = 10; N = DFF; rowmode = 2; cmo = CW_COLMAX + DFF; soff = 0; doff = WS_FGU; n0 = 32 * (sidx - STRIPS_WIN - STRIPS_FF); }
    else { in = 2; N = INC; rowmode = 0; cmo = CW_COLMAX_WIN + INC; soff = (size_t)D * INC; doff = WS_WIN + (size_t)INC * D * 2; n0 = 32 * (sidx - STRIPS_WIN - 2 * STRIPS_FF); }
    StripDesc d; d.W = A->in[in] + soff; d.WT = A->ws + doff; d.cm = (unsigned*)(A->ws + WS_CTL) + cmo; d.N = N; d.rowmode = rowmode; d.n0 = n0; return d;
}
__device__ __forceinline__ void strip_load(const StripDesc& d, int wave, int lane, int half, f32x4 (&v)[16]) {
    const float* p = d.W + (size_t)(256 * wave + 128 * half + (lane >> 3)) * d.N + d.n0 + 4 * (lane & 7);
#pragma unroll
    for (int it = 0; it < 16; ++it) v[it] = __builtin_nontemporal_load((const f32x4*)(p + (size_t)(8 * it) * d.N));
}
__device__ __forceinline__ void strip_park(LAS unsigned char* lds, int wave, int lane, int half, const f32x4 (&v)[16], float (&mx)[4]) {
    const int c = lane & 7, r8 = lane >> 3;
#pragma unroll
    for (int it = 0; it < 16; ++it) { const int k = 256 * wave + 128 * half + 8 * it + r8;
        mx[0] = fmaxf(mx[0], fabsf(v[it].x)); mx[1] = fmaxf(mx[1], fabsf(v[it].y)); mx[2] = fmaxf(mx[2], fabsf(v[it].z)); mx[3] = fmaxf(mx[3], fabsf(v[it].w));
        *(LAS u32x2_t*)(lds + k * 64 + ((c ^ ((k >> 4) & 7)) * 8)) = (u32x2_t){pk2(v[it].x, v[it].y), pk2(v[it].z, v[it].w)}; }
}
__device__ __forceinline__ void strips_to_i8(ArgsP A, LAS unsigned char* lds, int first, int stride, int wave, int lane, int last = N_STRIPS) {
    const int c = lane & 7, r8 = lane >> 3;
    f32x4 v0[16], v1[16];
    if (first < last) { const StripDesc d0 = strip_lookup(A, first); strip_load(d0, wave, lane, 0, v0); strip_load(d0, wave, lane, 1, v1); }
    for (int sidx = first; sidx < last; sidx += stride) {
        const StripDesc d = strip_lookup(A, sidx);
        float mx[4] = {0.f, 0.f, 0.f, 0.f};
        strip_park(lds, wave, lane, 0, v0, mx);
        strip_park(lds, wave, lane, 1, v1, mx);
        LAS float* red = (LAS float*)(lds + LDSCTL_OFF + 2048);
#pragma unroll
        for (int j = 0; j < 4; ++j) { float x = mx[j]; x = fmaxf(x, xor_lt32<8>(x)); x = fmaxf(x, xor_lt32<16>(x)); x = half_max(x); mx[j] = x; }
        if (lane < 8) *(LAS f32x4*)(red + wave * 32 + 4 * lane) = (f32x4){mx[0], mx[1], mx[2], mx[3]};
        __syncthreads();
        if (sidx + stride < last) { const StripDesc dn = strip_lookup(A, sidx + stride); strip_load(dn, wave, lane, 0, v0); strip_load(dn, wave, lane, 1, v1); }
        f32x4 m = *(const LAS f32x4*)(red + 4 * c);
#pragma unroll
        for (int w = 1; w < 8; ++w) { const f32x4 t = *(const LAS f32x4*)(red + w * 32 + 4 * c); m.x = fmaxf(m.x, t.x); m.y = fmaxf(m.y, t.y); m.z = fmaxf(m.z, t.z); m.w = fmaxf(m.w, t.w); }
        if (wave == 0 && lane < 8) *(v4u*)(d.cm + d.n0 + 4 * lane) = (v4u){__float_as_uint(m.x), __float_as_uint(m.y), __float_as_uint(m.z), __float_as_uint(m.w)};
        float sc[4]; sc[0] = m.x > 0.f ? 127.0f / m.x : 0.f; sc[1] = m.y > 0.f ? 127.0f / m.y : 0.f; sc[2] = m.z > 0.f ? 127.0f / m.z : 0.f; sc[3] = m.w > 0.f ? 127.0f / m.w : 0.f;
#pragma unroll
        for (int u = 0; u < 2; ++u) { const int kt = 2 * wave + u, q = r8;
            v4u a[4];
#pragma unroll
            for (int hh = 0; hh < 2; ++hh) {
                float wv[8][4];
#pragma unroll
                for (int it = 0; it < 8; ++it) { const int k = 128 * kt + 16 * q + 8 * hh + it; const u32x2_t x = *(const LAS u32x2_t*)(lds + k * 64 + ((c ^ q) * 8));
                    wv[it][0] = bflo(x.x); wv[it][1] = bfhi(x.x); wv[it][2] = bflo(x.y); wv[it][3] = bfhi(x.y); }
#pragma unroll
                for (int j = 0; j < 4; ++j) { const float sj = sc[j];
                    const unsigned lo = pk4_i8(wv[0][j] * sj, wv[1][j] * sj, wv[2][j] * sj, wv[3][j] * sj), hi = pk4_i8(wv[4][j] * sj, wv[5][j] * sj, wv[6][j] * sj, wv[7][j] * sj);
                    if (hh == 0) { a[j].x = lo; a[j].y = hi; } else { a[j].z = lo; a[j].w = hi; } } }
#pragma unroll
            for (int j = 0; j < 4; ++j) { const int n = d.n0 + 4 * c + j; const int nr = d.rowmode == 0 ? n : (256 * (n >> 7) + (n & 127) + (d.rowmode == 2 ? 128 : 0));
                __builtin_nontemporal_store(a[j], (v4u*)(d.WT + (size_t)nr * D + 128 * kt + 16 * q)); } }
        __syncthreads();
    }
}
template <int R> __device__ __forceinline__ void rms_rows_to_i8(const float* X, const float* gain, unsigned char* H8, float* rowscale, int m0, int stride, int lane) {
    f32x4 v[R][8];
#pragma unroll
    for (int r = 0; r < R; ++r) { const int m = (m0 + r * stride) < M ? (m0 + r * stride) : m0; const f32x4* xr = (const f32x4*)(X + (size_t)m * D) + lane;
#pragma unroll
        for (int j = 0; j < 8; ++j) v[r][j] = xr[64 * j]; }
    const f32x4* gr = (const f32x4*)gain + lane;
#pragma unroll
    for (int r = 0; r < R; ++r) { float t = 0.f;
#pragma unroll
        for (int j = 0; j < 8; ++j) t += (v[r][j].x * v[r][j].x + v[r][j].y * v[r][j].y) + (v[r][j].z * v[r][j].z + v[r][j].w * v[r][j].w);
        const float rstd = 1.0f / sqrtf(wave_sum(t) * (1.f / D) + RMS_EPS); float mx = 0.f;
#pragma unroll
        for (int j = 0; j < 8; ++j) { const f32x4 g = gr[64 * j]; v[r][j].x *= rstd * g.x; v[r][j].y *= rstd * g.y; v[r][j].z *= rstd * g.z; v[r][j].w *= rstd * g.w;
            mx = fmaxf(mx, fmaxf(fmaxf(fabsf(v[r][j].x), fabsf(v[r][j].y)), fmaxf(fabsf(v[r][j].z), fabsf(v[r][j].w)))); }
        mx = wave_max(mx); const float s = mx > 0.f ? 127.0f / mx : 0.f;
        if ((m0 + r * stride) < M) { const int m = m0 + r * stride; if (lane == 0) rowscale[m] = mx * (1.0f / 127.0f);
#pragma unroll
            for (int j = 0; j < 8; ++j) ((unsigned*)(H8 + (size_t)m * D) + lane)[64 * j] = pk4_i8(v[r][j].x * s, v[r][j].y * s, v[r][j].z * s, v[r][j].w * s); } }
}

template <int R> __device__ __forceinline__ void rms_rows_to_bf16(const float* X, const float* gain, bf16* H, int m0, int stride, int lane) {
    f32x4 v[R][8]; float s[R];
#pragma unroll
    for (int r = 0; r < R; ++r) { const int m = (m0 + r * stride) < M ? (m0 + r * stride) : m0; const f32x4* xr = (const f32x4*)(X + (size_t)m * D) + lane;
#pragma unroll
        for (int j = 0; j < 8; ++j) v[r][j] = xr[64 * j]; }
#pragma unroll
    for (int r = 0; r < R; ++r) { float t = 0.f;
#pragma unroll
        for (int j = 0; j < 8; ++j) t += (v[r][j].x * v[r][j].x + v[r][j].y * v[r][j].y) + (v[r][j].z * v[r][j].z + v[r][j].w * v[r][j].w);
        s[r] = 1.0f / sqrtf(wave_sum(t) * (1.f / D) + RMS_EPS); }
    const f32x4* gr = (const f32x4*)gain + lane;
#pragma unroll
    for (int j = 0; j < 8; ++j) { const f32x4 g = gr[64 * j];
#pragma unroll
        for (int r = 0; r < R; ++r) if ((m0 + r * stride) < M) { v2u w; w.x = pk2(v[r][j].x * s[r] * g.x, v[r][j].y * s[r] * g.y); w.y = pk2(v[r][j].z * s[r] * g.z, v[r][j].w * s[r] * g.w);
            ((v2u*)(H + (size_t)(m0 + r * stride) * D) + lane)[64 * j] = w; } }
}

__device__ __forceinline__ void attn_item(const bf16* Q, const bf16* K2, const bf16* V3, bf16* Y, int b, int h, int qb, int lane) {
    const int r = lane & 31, hh = lane >> 5, q0 = qb * 32;
    const size_t tok0 = (size_t)b * SEQ;
    const int bh = b * 8 + h;
    bf16x8 qf[8];
    { const bf16* qrow = Q + (tok0 + q0 + r) * 1024 + h * 128 + 8 * hh;
#pragma unroll
      for (int s = 0; s < 8; ++s) qf[s] = *(const bf16x8*)(qrow + 16 * s); }
    const float nscale = -0.08838834764831845f * 1.4426950408889634f;
    f32x16 o[4];
#pragma unroll
    for (int dt = 0; dt < 4; ++dt)
#pragma unroll
        for (int i = 0; i < 16; ++i) o[dt][i] = 0.f;
    float Pc = 1.0f;
    bf16x8 kf[8];
    { const bf16* kp = K2 + ((size_t)((bh * 128 + qb) * 8) * 64 + lane) * 8;
#pragma unroll
      for (int s = 0; s < 8; ++s) kf[s] = *(const bf16x8*)(kp + (size_t)s * 512); }
    for (int kb = qb; kb >= 0; --kb) {
        bf16x8 vf[4][2];
        { const bf16* vp = V3 + ((size_t)((bh * 128 + kb) * 8) * 64 + lane) * 8;
#pragma unroll
          for (int dt = 0; dt < 4; ++dt)
#pragma unroll
              for (int s = 0; s < 2; ++s) vf[dt][s] = *(const bf16x8*)(vp + (size_t)(dt * 2 + s) * 512); }
        bf16x8 kn[8];
        { const int kbn = kb > 0 ? kb - 1 : 0; const bf16* kp = K2 + ((size_t)((bh * 128 + kbn) * 8) * 64 + lane) * 8;
#pragma unroll
          for (int s = 0; s < 8; ++s) kn[s] = *(const bf16x8*)(kp + (size_t)s * 512); }
        f32x16 st;
#pragma unroll
        for (int i = 0; i < 16; ++i) st[i] = 0.f;
#pragma unroll
        for (int s = 0; s < 8; ++s) st = __builtin_amdgcn_mfma_f32_32x32x16_bf16(kf[s], qf[s], st, 0, 0, 0);
        const bool diag = (kb == qb);
        float bv[16], nv[16], gp[4];
#pragma unroll
        for (int g = 0; g < 4; ++g) { float pg_ = 1.f;
#pragma unroll
            for (int u = 0; u < 4; ++u) { const int i = 4 * g + u; const float z = st[i];
                const bool valid = !diag || ((u + 8 * g + 4 * hh) < r);
                const float e = __builtin_amdgcn_exp2f(fabsf(z) * nscale);
                const float t = __builtin_amdgcn_rcpf(1.0f + e), et = e * t;
                const float beta = z >= 0.f ? t : et, nn = z >= 0.f ? et : t;
                bv[i] = valid ? beta : 0.f; nv[i] = valid ? nn : 1.f; pg_ *= nv[i]; }
            gp[g] = pg_; }
        float pp[4];
#pragma unroll
        for (int g = 0; g < 4; ++g) pp[g] = other_half(gp[g], hh);
        float tail[4]; float run = 1.f;
#pragma unroll
        for (int g = 3; g >= 0; --g) { tail[g] = run * (hh == 0 ? pp[g] : 1.f); run *= gp[g] * pp[g]; }
        unsigned pw[8];
#pragma unroll
        for (int g = 0; g < 4; ++g) { float a[4]; float suf = Pc * tail[g];
#pragma unroll
            for (int u = 3; u >= 0; --u) { const int i = 4 * g + u; a[u] = bv[i] * suf; suf *= nv[i]; }
            pw[2 * g] = pk2(a[0], a[1]); pw[2 * g + 1] = pk2(a[2], a[3]); }
        Pc *= run;
        bf16x8 pf[2];
        { v4u t0 = {pw[0], pw[1], pw[2], pw[3]}, t1 = {pw[4], pw[5], pw[6], pw[7]}; pf[0] = __builtin_bit_cast(bf16x8, t0); pf[1] = __builtin_bit_cast(bf16x8, t1); }
#pragma unroll
        for (int dt = 0; dt < 4; ++dt)
#pragma unroll
            for (int s = 0; s < 2; ++s) o[dt] = __builtin_amdgcn_mfma_f32_32x32x16_bf16(vf[dt][s], pf[s], o[dt], 0, 0, 0);
        if (__builtin_amdgcn_ballot_w64(Pc != 0.0f) == 0ull) break;
#pragma unroll
        for (int s = 0; s < 8; ++s) kf[s] = kn[s];
    }
    bf16* yrow = Y + (tok0 + q0 + r) * 1024 + h * 128 + 4 * hh;
#pragma unroll
    for (int dt = 0; dt < 4; ++dt)
#pragma unroll
        for (int g = 0; g < 4; ++g) { v2u w; w.x = pk2(o[dt][4 * g], o[dt][4 * g + 1]); w.y = pk2(o[dt][4 * g + 2], o[dt][4 * g + 3]); *(v2u*)(yrow + 32 * dt + 8 * g) = w; }
}

template <int W> __device__ __forceinline__ void pool_window(const bf16* up, bf16* dst, int s) {
    v4u rows[W];
#pragma unroll
    for (int j = 0; j < W; ++j) rows[j] = *(const v4u*)(up - (size_t)((j <= s) ? j : 0) * 1024);
    float sm[8] = {0.f, 0.f, 0.f, 0.f, 0.f, 0.f, 0.f, 0.f};
#pragma unroll
    for (int j = 0; j < W; ++j) { const float m = (j <= s) ? 1.0f : 0.0f; const v4u u = rows[j];
        sm[0] += m * bflo(u.x); sm[1] += m * bfhi(u.x); sm[2] += m * bflo(u.y); sm[3] += m * bfhi(u.y); sm[4] += m * bflo(u.z); sm[5] += m * bfhi(u.z); sm[6] += m * bflo(u.w); sm[7] += m * bfhi(u.w); }
    const int cnt = (s + 1) < W ? (s + 1) : W; const float inv = 1.0f / (float)cnt; const v4u u0 = rows[0];
    v4u o; o.x = pk2(sm[0] * inv - bflo(u0.x), sm[1] * inv - bfhi(u0.x)); o.y = pk2(sm[2] * inv - bflo(u0.y), sm[3] * inv - bfhi(u0.y));
    o.z = pk2(sm[4] * inv - bflo(u0.z), sm[5] * inv - bfhi(u0.z)); o.w = pk2(sm[6] * inv - bflo(u0.w), sm[7] * inv - bfhi(u0.w));
    *(v4u*)dst = o;
}

constexpr int NPH = 20;
__device__ __forceinline__ int lau(int x) { asm volatile("" : "+s"(x)); return x; }
__device__ __forceinline__ int lauv(int x) { asm volatile("" : "+v"(x)); return x; }
__device__ __forceinline__ void moe_tile_starts(const unsigned* ecnt, int (&ts)[9]) {
    asm volatile("" : "+s"(ecnt));
    ts[0] = 0;
#pragma unroll
    for (int e = 0; e < 8; ++e) { const int c = (int)__builtin_amdgcn_readfirstlane(__hip_atomic_load(ecnt + 64 * e, RLX_AGENT)); ts[e + 1] = ts[e] + ((c + 255) >> 8); }
}

#if MK_PER_PHASE
#define GRID_BAR() do { } while (0)
#else
#define GRID_BAR() xcd_barrier(bar)
#endif
#define IN(k) (lo <= (k) && (k) < hi)
#define SEAM(k) do { if (IN(k) && IN((k) + 1)) GRID_BAR(); } while (0)
#define WSP(T, off) ((T*)(A->ws + (off)))
#define PH_LOCALS() const int wave = lau(wave0), lane = pg8::lane_id_now(), tid = wave * 64 + lane, gw = lau(gw0); (void)tid; (void)lane; (void)wave; (void)gw
constexpr int HK_NBAL = N_STRIPS % 256, HK_BAL_TILES = (256 - HK_NBAL) * 16;
constexpr int HK_D0 = SEG_D0 + 2 * POOL_CVT + 2 * PROJ_CVT + FGU_CVT + HK_BAL_TILES;
constexpr int HKN_PROJ = (HK_MASK & 1) ? HK_TPU * 1024 : 0, HKN_MRG = (HK_MASK & 2) ? HK_TPU * 256 : 0, HKN_OUT = (HK_MASK & 4) ? HK_TPU * 256 : 0, HKN_FGU = (HK_MASK & 8) ? HK_TPU * 1408 : 0, HKN_FD = (HK_MASK & 16) ? HK_TPU * 256 : 0;
constexpr int FGU_STG = (STG_MASK & 8) ? (FGU_G / 2) * NWAVES * 6 + 672 : 0;
constexpr int PROJ_STGB = (STG_MASK & 1) ? 4096 : 0, PROJ_STGA = (STG_MASK & 1) ? 4096 : 0;
constexpr int HK_PROJ0 = HK_D0, HK_PS0 = HK_PROJ0 + HKN_PROJ, HK_E1_0 = HK_PS0 + PROJ_STGB + PROJ_STGA, HK_E2_0 = HK_E1_0 + HKN_MRG, HK_OUT0 = HK_E2_0 + HKN_MRG, HK_FGU = HK_OUT0 + HKN_OUT, HK_FGUS = HK_FGU + HKN_FGU,
              HK_FD = HK_FGUS + 2 * FGU_STG, HK_PROJ1 = HK_FD + HKN_FD, HK_PS1 = HK_PROJ1 + HKN_PROJ, HK_E1_1 = HK_PS1 + PROJ_STGB + PROJ_STGA, HK_E2_1 = HK_E1_1 + HKN_MRG, HK_OUT1 = HK_E2_1 + HKN_MRG,
              HK_DEND = HK_OUT1 + HKN_OUT;
static_assert(HK_DEND <= SEG_E0, "hook plan inside SEG_D");
template <int BIT> __device__ __forceinline__ CvtHookT<(HK_MASK & BIT) != 0> hook_range(bool on, int first, int count) { CvtHookT<(HK_MASK & BIT) != 0> h; h.first = first; h.last = on ? first + count : first; return h; }
template <int L> __device__ __forceinline__ void layer_phases(LAS unsigned char* lds, const int G, const int bx, const int vcu, const int gw0, const int wave0, const int NGW, const int lo, const int hi, const XcdBarrier bar) {
    constexpr int l = L;
        const int pb = 1 + 9 * l;
        if (IN(pb + 0)) {
            ArgsP A = argp();
            pg8::StaticOrder<M / 256, INC / 256, D / 2, D / 2, 0> S{lau(G), lau(bx)};
            pg8::EpiProj E{WSP(bf16, WS_UPOOL), WSP(bf16, WS_Q), WSP(bf16, WS_K), WSP(bf16, WS_VT), WSP(bf16, WS_GATES), WSP(const float, WS_TOK + 262144), WSP(const unsigned, WS_CTL) + CW_COLMAX_WIN + l * INC};
            const auto HK = hook_range<1>(G == 256, l == 0 ? HK_PROJ0 : HK_PROJ1, HKN_PROJ);
            if (G == 256 && PROJ_STGB > 0 && !(bx & 1)) {
                PH_LOCALS(); const int ps = l == 0 ? HK_PS0 : HK_PS1;
                cvt_range_big(A, SEG_D0 + 2 * POOL_CVT + l * PROJ_CVT, SEG_D0 + 2 * POOL_CVT + (l + 1) * PROJ_CVT, (bx >> 1) * NWAVES + wave, 128 * NWAVES, lane);
                if (l == 0 && STRIPS_HOSTED) {
                    constexpr int XB = (128 - 48) * 16;
                    if ((bx >> 1) >= 48) cvt_range_big(A, ps, ps + XB, ((bx >> 1) - 48) * NWAVES + wave, (128 - 48) * NWAVES, lane);
                    cvt_range_big(A, ps + XB, ps + PROJ_STGB, (bx >> 1) * NWAVES + wave, 128 * NWAVES, lane);
                } else
                cvt_range_big(A, ps, ps + PROJ_STGB, (bx >> 1) * NWAVES + wave, 128 * NWAVES, lane);
                if (l == 0) cvt_range(A, SEG_A0 + T_WIN, SEG_B0, (bx >> 1) * NWAVES + wave, 128 * NWAVES, lane);
                if (l == 0 && STRIPS_HOSTED) strips_to_i8(A, lds + RING_OFF, STRIPS_WIN + (bx >> 1), 128, wave, lane, STRIPS_WIN + HOSTED_HALF); }
            pg8::gemm_phase<D / 2, D / 2, D / 2, pg8::EpiProj, decltype(S), true, false, 2, false, decltype(HK)>(lds + RING_OFF, WSP(const bf16, WS_H), WSP(const bf16, WS_WIN) + (size_t)l * INC * D, S, E, lau(wave0), HK);
            if (G == 256 && PROJ_STGB > 0) { if (bx & 1) { PH_LOCALS(); const int ps = (l == 0 ? HK_PS0 : HK_PS1) + PROJ_STGB;
                    if (l == 0 && STRIPS_HOSTED) { constexpr int XB = (128 - 48) * 16;
                        if ((bx >> 1) >= 48) cvt_range_big(A, ps, ps + XB, ((bx >> 1) - 48) * NWAVES + wave, (128 - 48) * NWAVES, lane);
                        cvt_range_big(A, ps + XB, ps + PROJ_STGA, (bx >> 1) * NWAVES + wave, 128 * NWAVES, lane);
                    } else
                    cvt_range_big(A, ps, ps + PROJ_STGA, (bx >> 1) * NWAVES + wave, 128 * NWAVES, lane);
                    if (l == 0) cvt_range(A, SEG_B0 + 2 * T_FF8, SEG_C0, (bx >> 1) * NWAVES + wave, 128 * NWAVES, lane);
                    if (l == 0 && STRIPS_HOSTED) strips_to_i8(A, lds + RING_OFF, STRIPS_WIN + HOSTED_HALF + (bx >> 1), 128, wave, lane, N_STRIPS); } }
            else if (G == 256 && !(bx & 1)) {
                PH_LOCALS(); cvt_range_big(A, SEG_D0 + 2 * POOL_CVT + l * PROJ_CVT, SEG_D0 + 2 * POOL_CVT + (l + 1) * PROJ_CVT, (bx >> 1) * NWAVES + wave, 128 * NWAVES, lane); }
        }
        SEAM(pb + 0);
        if (IN(pb + 1)) {
            ArgsP A = argp(); PH_LOCALS();
            const bf16 *Qb = WSP(const bf16, WS_Q), *Kb = WSP(const bf16, WS_K), *VT = WSP(const bf16, WS_VT); bf16* YATTN = WSP(bf16, WS_YATTN);
            for (int rep = 0; rep < ((PROBE_DUP & 2) ? 2 : 1); ++rep) {
            for (int it = gw; it < 2048; it += NGW) {
                const int blk = it >> 3, w = it & 7, bh = blk >> 4, i = blk & 15;
                const int qb = (w < 4) ? (4 * i + w) : (127 - (4 * i + (w - 4)));
                attn_item(Qb, Kb, VT, YATTN, bh >> 3, bh & 7, qb, lane);
            }
            const bf16* UPOOL = WSP(const bf16, WS_UPOOL); bf16* POOLED = WSP(bf16, WS_POOLED);
            for (int wi = gw; wi < 2 * M; wi += NGW) {
                const int g = ((wi & 3) + wi / NGW) & 3, pair = wi >> 2;
                const int tok = 2 * pair + (lane >> 5), cc = 32 * g + (lane & 31), s = tok & (SEQ - 1);
                const bf16* up = UPOOL + (size_t)tok * 1024 + cc * 8;
                if (g == 0) pool_window<2>(up, POOLED + (size_t)tok * 1024 + cc * 8, s);
                else if (g == 1) pool_window<4>(up, POOLED + (size_t)tok * 1024 + cc * 8, s);
                else if (g == 2) pool_window<8>(up, POOLED + (size_t)tok * 1024 + cc * 8, s);
                else pool_window<16>(up, POOLED + (size_t)tok * 1024 + cc * 8, s);
            }
            }
        }
        SEAM(pb + 1);
        if (IN(pb + 2)) {
            ArgsP A = argp();
            if (G == 256 && bx >= 128) {
                PH_LOCALS(); cvt_range_big(A, SEG_D0 + l * POOL_CVT, SEG_D0 + (l + 1) * POOL_CVT, (bx - 128) * NWAVES + wave, 128 * NWAVES, lane); }
            pg8::StaticOrder<M / 256, 4, PW, 256, 512> S{lau(G), lau(bx)};
            pg8::EpiPool E{WSP(bf16, WS_YPOOL), A->in[4] + (size_t)l * PW};
            pg8::gemm_phase<PW, 256, 256>(lds + RING_OFF, WSP(const bf16, WS_POOLED), WSP(const bf16, WS_POOLW) + (size_t)l * 4 * 65536, S, E, lau(wave0));
        }
        SEAM(pb + 2);
        if (IN(pb + 3)) {
            { ArgsP A = argp(); pg8::StaticOrder<M / 256, D / 256, PW, PW, 0> S{lau(G), lau(bx)};
              pg8::EpiGate<1> E{WSP(const bf16, WS_GATES), WSP(bf16, WS_T), WSP(bf16, WS_MERGED)};
              pg8::gemm_phase<PW, PW, PW>(lds + RING_OFF, WSP(const bf16, WS_YPOOL), WSP(const bf16, WS_WPU) + (size_t)l * D * PW, S, E, lau(wave0), hook_range<2>(G == 256, l == 0 ? HK_E1_0 : HK_E1_1, HKN_MRG)); }
            { ArgsP A = argp(); pg8::StaticOrder<M / 256, D / 256, PW, PW, 0> S{lau(G), lau(bx)};
              pg8::EpiGate<2> E{WSP(const bf16, WS_GATES), WSP(bf16, WS_T), WSP(bf16, WS_MERGED)};
              pg8::gemm_phase<PW, PW, PW>(lds + RING_OFF, WSP(const bf16, WS_YATTN), WSP(const bf16, WS_WAU) + (size_t)l * D * PW, S, E, lau(wave0), hook_range<2>(G == 256, l == 0 ? HK_E2_0 : HK_E2_1, HKN_MRG)); }
        }
        SEAM(pb + 3);
        if (IN(pb + 4)) {
            ArgsP A = argp();
            pg8::StaticOrder<M / 256, D / 256, D, D, 0> S{lau(G), lau(bx)};
            pg8::EpiResid E{l == 0 ? A->in[0] : WSP(const float, WS_X), WSP(float, WS_X)};
            pg8::gemm_phase<D, D, D>(lds + RING_OFF, WSP(const bf16, WS_MERGED), WSP(const bf16, WS_WOUT) + (size_t)l * D * D, S, E, lau(wave0), hook_range<4>(G == 256, l == 0 ? HK_OUT0 : HK_OUT1, HKN_OUT));
        }
        SEAM(pb + 4);
        if (l == 0) {
            if (IN(pb + 5)) { ArgsP A = argp(); PH_LOCALS(); const float* X = WSP(const float, WS_X); const float* gn = A->in[8];
                for (int m = gw; m < M; m += 4 * NGW) rms_rows_to_i8<4>(X, gn, WSP(unsigned char, WS_H), WSP(float, WS_TOK + 262144), m, NGW, lane);
}
            SEAM(pb + 5);
            if (IN(pb + 6)) {
                ArgsP A = argp();
                if (G == 256 && bx >= FGU_G) {
                    PH_LOCALS(); const int widx = (bx - FGU_G) * NWAVES + wave, nw = (256 - FGU_G) * NWAVES;
                    cvt_range(A, SEG_C0 + T_WIN, SEG_D0, widx, nw, lane);
                    cvt_range_big(A, SEG_D0 + 2 * POOL_CVT + 2 * PROJ_CVT, SEG_D0 + 2 * POOL_CVT + 2 * PROJ_CVT + FGU_CVT, widx, nw, lane);
                } else {
                    pg8::StaticOrder<M / 256, 2 * DFF / 256, D / 2, D / 2, 0> S{lau(G == 256 ? FGU_G : G), lau(bx)};
                    pg8::EpiSwiGLUi8 E{WSP(bf16, WS_G), WSP(const float, WS_TOK + 262144), WSP(const unsigned, WS_CTL) + CW_COLMAX};
                    if (G == 256 && FGU_STG > 0 && (bx & 1)) { PH_LOCALS(); cvt_range_big(A, HK_FGUS, HK_FGUS + FGU_STG, (bx >> 1) * NWAVES + wave, (FGU_G / 2) * NWAVES, lane); }
                    pg8::gemm_phase<D / 2, D / 2, D / 2, pg8::EpiSwiGLUi8, decltype(S), true, false, 2, false, CvtHookT<(HK_MASK & 8) != 0>>(lds + RING_OFF, WSP(const bf16, WS_H), WSP(const bf16, WS_FGU), S, E, lau(wave0), hook_range<8>(G == 256, HK_FGU, HKN_FGU));
                    if (G == 256 && FGU_STG > 0 && !(bx & 1)) { PH_LOCALS(); cvt_range_big(A, HK_FGUS + FGU_STG, HK_FGUS + 2 * FGU_STG, (bx >> 1) * NWAVES + wave, (FGU_G / 2) * NWAVES, lane); }
                }
            }
            SEAM(pb + 6);
            if (IN(pb + 7)) {
                ArgsP A = argp();
                pg8::StaticOrder<M / 256, D / 256, DFF, DFF, 0> S{lau(G), lau(bx)};
                pg8::EpiResid E{WSP(const float, WS_X), WSP(float, WS_X)};
                pg8::gemm_phase<DFF, DFF, DFF>(lds + RING_OFF, WSP(const bf16, WS_G), WSP(const bf16, WS_FD), S, E, lau(wave0), hook_range<16>(G == 256, HK_FD, HKN_FD));
            }
            SEAM(pb + 7);
            if (IN(pb + 8)) { ArgsP A = argp(); PH_LOCALS(); const float* X = WSP(const float, WS_X); const float* gn = A->in[1] + D;
                for (int m = gw; m < M; m += 4 * NGW) rms_rows_to_i8<4>(X, gn, WSP(unsigned char, WS_H), WSP(float, WS_TOK + 262144), m, NGW, lane); }
            SEAM(pb + 8);
        } else {
            if (IN(pb + 5)) {
                ArgsP A = argp(); PH_LOCALS();
                const float* X = WSP(const float, WS_X); bf16* H = WSP(bf16, WS_H);
                unsigned* ecnt = WSP(unsigned, WS_CTL) + CW_ECNT;
                int* TOKE = WSP(int, WS_TOK); int* TOKP = WSP(int, WS_TOK + 65536); float* TOKW = WSP(float, WS_TOK + 131072); int* INV = WSP(int, WS_CTL) + CW_INV;
                LAS int* lcnt = (LAS int*)(lds + RING_OFF);
                LAS int* lbase = lcnt + 8; LAS int* sel = lcnt + 16;
                const float* gain = A->in[8] + D; const float* wr = A->in[12];
                for (int ch = vcu; ch < M / 32; ch += G) {
                    if (tid < 8) lcnt[tid] = 0;
                    __syncthreads();
                    for (int half = 0; half < 2; ++half) {
                        f32x4 v[2][8]; float rs[2];
#pragma unroll
                        for (int i = 0; i < 2; ++i) { const f32x4* xr = (const f32x4*)(X + (size_t)(ch * 32 + wave * 4 + 2 * half + i) * D) + lane;
#pragma unroll
                            for (int j = 0; j < 8; ++j) v[i][j] = xr[64 * j]; }
#pragma unroll
                        for (int i = 0; i < 2; ++i) { float s = 0.f;
#pragma unroll
                            for (int j = 0; j < 8; ++j) s += (v[i][j].x * v[i][j].x + v[i][j].y * v[i][j].y) + (v[i][j].z * v[i][j].z + v[i][j].w * v[i][j].w);
                            rs[i] = 1.0f / sqrtf(wave_sum(s) * (1.f / D) + RMS_EPS); }
                        float lg[2][8];
#pragma unroll
                        for (int i = 0; i < 2; ++i)
#pragma unroll
                            for (int e = 0; e < 8; ++e) lg[i][e] = 0.f;
                        const f32x4* gr = (const f32x4*)gain + lane;
#pragma unroll
                        for (int j = 0; j < 8; ++j) { const f32x4 g = gr[64 * j];
#pragma unroll
                            for (int i = 0; i < 2; ++i) { f32x4 hn; hn.x = v[i][j].x * rs[i] * g.x; hn.y = v[i][j].y * rs[i] * g.y; hn.z = v[i][j].z * rs[i] * g.z; hn.w = v[i][j].w * rs[i] * g.w; v[i][j] = hn;
                                ((unsigned*)((unsigned char*)H + (size_t)(ch * 32 + wave * 4 + 2 * half + i) * D) + lane)[64 * j] = pg8::pk4_fp8(hn.x * pg8::FP8_H_SCALE, hn.y * pg8::FP8_H_SCALE, hn.z * pg8::FP8_H_SCALE, hn.w * pg8::FP8_H_SCALE); }
                            const f32x4* wp = (const f32x4*)(wr + (size_t)(4 * (lane + 64 * j)) * 8);
#pragma unroll
                            for (int c = 0; c < 4; ++c) { const f32x4 w0 = wp[2 * c], w1 = wp[2 * c + 1];
#pragma unroll
                                for (int i = 0; i < 2; ++i) { const float hv = v[i][j][c];
                                    lg[i][0] += hv * w0.x; lg[i][1] += hv * w0.y; lg[i][2] += hv * w0.z; lg[i][3] += hv * w0.w; lg[i][4] += hv * w1.x; lg[i][5] += hv * w1.y; lg[i][6] += hv * w1.z; lg[i][7] += hv * w1.w; } }
                            asm volatile("" : "+v"(lg[0][0]), "+v"(lg[0][1]), "+v"(lg[0][2]), "+v"(lg[0][3]), "+v"(lg[0][4]), "+v"(lg[0][5]), "+v"(lg[0][6]), "+v"(lg[0][7]),
                                              "+v"(lg[1][0]), "+v"(lg[1][1]), "+v"(lg[1][2]), "+v"(lg[1][3]), "+v"(lg[1][4]), "+v"(lg[1][5]), "+v"(lg[1][6]), "+v"(lg[1][7]) :: "memory"); }
#pragma unroll
                        for (int i = 0; i < 2; ++i) { const int tl = wave * 4 + 2 * half + i;
#pragma unroll
                            for (int e = 0; e < 8; ++e) lg[i][e] = wave_sum(lg[i][e]);
                            int e1 = 0; float v1 = lg[i][0];
#pragma unroll
                            for (int e = 1; e < 8; ++e) if (lg[i][e] > v1) { v1 = lg[i][e]; e1 = e; }
                            int e2 = -1; float v2 = -3.0e38f;
#pragma unroll
                            for (int e = 0; e < 8; ++e) if (e != e1 && lg[i][e] > v2) { v2 = lg[i][e]; e2 = e; }
                            if (lane == 0) { const float w1 = 1.0f / (1.0f + expf(v2 - v1));
                                const int p1 = __hip_atomic_fetch_add(lcnt + e1, 1, __ATOMIC_RELAXED, __HIP_MEMORY_SCOPE_WORKGROUP), p2 = __hip_atomic_fetch_add(lcnt + e2, 1, __ATOMIC_RELAXED, __HIP_MEMORY_SCOPE_WORKGROUP);
                                sel[tl * 6 + 0] = e1; sel[tl * 6 + 1] = e2; sel[tl * 6 + 2] = p1; sel[tl * 6 + 3] = p2; ((LAS float*)sel)[tl * 6 + 4] = w1; ((LAS float*)sel)[tl * 6 + 5] = 1.0f - w1; } }
                    }
                    __syncthreads();
                    if (tid < 8) lbase[tid] = (int)__hip_atomic_fetch_add(ecnt + 64 * tid, (unsigned)lcnt[tid], RLX_AGENT);
                    __syncthreads();
                    if (tid < 32) { const int tok = ch * 32 + tid; const int e1 = sel[tid * 6], e2 = sel[tid * 6 + 1];
                        TOKE[2 * tok] = e1; TOKE[2 * tok + 1] = e2; TOKP[2 * tok] = lbase[e1] + sel[tid * 6 + 2]; TOKP[2 * tok + 1] = lbase[e2] + sel[tid * 6 + 3];
                        INV[e1 * 8192 + lbase[e1] + sel[tid * 6 + 2]] = tok; INV[e2 * 8192 + lbase[e2] + sel[tid * 6 + 3]] = tok;
                        TOKW[2 * tok] = ((LAS float*)sel)[tid * 6 + 4]; TOKW[2 * tok + 1] = ((LAS float*)sel)[tid * 6 + 5]; }
                    __syncthreads();
                }
            }
            SEAM(pb + 5);
            if (IN(pb + 7)) {
                ArgsP A = argp();
                pg8::MoeOrder<2 * DFF / 256, D / 2, D / 2, (size_t)2 * DFF * D> S; moe_tile_starts(WSP(const unsigned, WS_CTL) + CW_ECNT, S.ts); S.inv = WSP(const int, WS_CTL) + CW_INV;
                const int units = S.ts[8] * (2 * DFF / 256), rounds = (units + G - 1) / G; int Gg = ((units + rounds - 1) / rounds + 7) & ~7; if (Gg > G || (G & 7)) Gg = G;
                const bool hk = (G == 256);
                int hkn = (hk && (HK_MASK & 32)) ? HK_TPU * units : 0; if (hkn > 8 * T_FF8) hkn = 8 * T_FF8;
                if (hk) Gg = G;
                int stg = hk ? MOE_STG : 0; if (2 * stg > 8 * T_FF8 - hkn) stg = (8 * T_FF8 - hkn) / 2;
                const int ncv = G - Gg; int q17 = ncv * rounds * CONV_TILES_PER_CU_ROUND_F8; if (q17 > 8 * T_FF8 - hkn - 2 * stg) q17 = 8 * T_FF8 - hkn - 2 * stg;
                CvtHookT<(HK_MASK & 32) != 0> HK; HK.first = SEG_E0; HK.last = SEG_E0 + hkn;
                if (bx >= Gg) { PH_LOCALS(); cvt_range_big(A, SEG_E0 + hkn + 2 * stg, SEG_E0 + hkn + 2 * stg + q17, (bx - Gg) * NWAVES + wave, ncv * NWAVES, lane); }
                else { S.G = lau(Gg); S.c = lau((bx % 8) * (Gg / 8) + bx / 8);
                    if (stg > 0 && (bx & 1)) { PH_LOCALS(); cvt_range_big(A, SEG_E0 + hkn, SEG_E0 + hkn + stg, (bx >> 1) * NWAVES + wave, 128 * NWAVES, lane); }
                    pg8::EpiSwiGLU8 E{WSP(unsigned char, WS_G)};
                    pg8::gemm_phase<D / 2, D / 2, D / 2, pg8::EpiSwiGLU8, decltype(S), true, false, 1, true, decltype(HK)>(lds + RING_OFF, WSP(const bf16, WS_H), WSP(const bf16, WS_MGU), S, E, lau(wave0), HK);
                    if (stg > 0 && !(bx & 1)) { PH_LOCALS(); cvt_range_big(A, SEG_E0 + hkn + stg, SEG_E0 + hkn + 2 * stg, (bx >> 1) * NWAVES + wave, 128 * NWAVES, lane); } }
                { PH_LOCALS(); cvt_range_big(A, SEG_E0 + hkn + 2 * stg + q17, CVT_TILES, gw, NGW, lane); }
            }
            SEAM(pb + 7);
            if (IN(pb + 8)) {
                ArgsP A = argp();
                pg8::TailSplitOrder<D / 256, DFF / 2, DFF / 2, DFF / 256, (size_t)D * DFF> S; S.G = lau(G); S.c = lau(vcu); moe_tile_starts(WSP(const unsigned, WS_CTL) + CW_ECNT, S.ts);
                pg8::EpiPart E{WSP(bf16, WS_Y), WSP(bf16, WS_Y2), 1.0f / (pg8::FP8_W_SCALE * pg8::FP8_G_SCALE)};
                pg8::gemm_phase<DFF / 2, DFF / 2, DFF / 2, pg8::EpiPart, decltype(S), true, true, true>(lds + RING_OFF, WSP(const bf16, WS_G), WSP(const bf16, WS_MD), S, E, lau(wave0));
            }
            SEAM(pb + 8);
            if (IN(pb + 9)) {
                ArgsP A = argp(); PH_LOCALS();
                int ts[9]; moe_tile_starts(WSP(const unsigned, WS_CTL) + CW_ECNT, ts);
                const int* TOKE = WSP(const int, WS_TOK); const int* TOKP = WSP(const int, WS_TOK + 65536); const float* TOKW = WSP(const float, WS_TOK + 131072);
                const float* X = WSP(const float, WS_X); const bf16* Yb = WSP(const bf16, WS_Y); const bf16* Y2 = WSP(const bf16, WS_Y2); const float* gfin = A->in[16]; float* out = A->out;
                const f32x4* gr = (const f32x4*)gfin + 2 * lane;
                int tF, tR, tsp; { pg8::TailSplitOrder<D / 256, DFF / 2, DFF / 2, DFF / 256, (size_t)D * DFF> TS; TS.G = G; TS.c = 0;
#pragma unroll
                    for (int e = 0; e < 9; ++e) TS.ts[e] = ts[e];
                    TS.tail_split(tF, tR, tsp); (void)tR; }
                for (int t0 = gw; t0 < M; t0 += 2 * NGW) {
                    size_t r1[2], r2[2]; float w1[2], w2[2]; int tk[2]; int lb[2][2], lt[2][2], rit[2][2];
#pragma unroll
                    for (int q = 0; q < 2; ++q) { const int tok = (t0 + q * NGW) < M ? (t0 + q * NGW) : t0; tk[q] = tok;
                        const int e1 = TOKE[2 * tok], e2 = TOKE[2 * tok + 1], p1 = TOKP[2 * tok], p2 = TOKP[2 * tok + 1];
                        w1[q] = TOKW[2 * tok]; w2[q] = TOKW[2 * tok + 1];
                        int o1 = 0, o2 = 0, n1 = 0, n2 = 0;
#pragma unroll
                        for (int e = 0; e < 8; ++e) { if (e == e1) { o1 = ts[e]; n1 = ts[e + 1]; } if (e == e2) { o2 = ts[e]; n2 = ts[e + 1]; } }
                        r1[q] = (size_t)(o1 * 256 + p1) * D; r2[q] = (size_t)(o2 * 256 + p2) * D;
                        lb[q][0] = o1 * 8 + (p1 >> 8); lt[q][0] = n1 - o1; rit[q][0] = p1 & 255; lb[q][1] = o2 * 8 + (p2 >> 8); lt[q][1] = n2 - o2; rit[q][1] = p2 & 255; }
                    v4u ya[2][4][4]; f32x4 v[2][8];
#pragma unroll
                    for (int q = 0; q < 2; ++q) { const f32x4* xr = (const f32x4*)(X + (size_t)tk[q] * D) + 2 * lane;
                        const v4u* ya1 = (const v4u*)(Yb + r1[q]) + lane; const v4u* yb1 = (const v4u*)(Y2 + r1[q]) + lane; const v4u* ya2 = (const v4u*)(Yb + r2[q]) + lane; const v4u* yb2 = (const v4u*)(Y2 + r2[q]) + lane;
#pragma unroll
                        for (int jj = 0; jj < 4; ++jj) { ya[q][jj][0] = ya1[64 * jj]; ya[q][jj][2] = ya2[64 * jj]; if (MOE_DOWN_KSPLIT == 2) { ya[q][jj][1] = yb1[64 * jj]; ya[q][jj][3] = yb2[64 * jj]; } else { ya[q][jj][1] = (v4u){0u, 0u, 0u, 0u}; ya[q][jj][3] = (v4u){0u, 0u, 0u, 0u}; } v[q][2 * jj] = xr[128 * jj]; v[q][2 * jj + 1] = xr[128 * jj + 1]; } }
                    if (tsp > 1) {
#pragma unroll
                        for (int q = 0; q < 2; ++q)
#pragma unroll
                            for (int sl = 0; sl < 2; ++sl)
#pragma unroll
                                for (int jj = 0; jj < 4; ++jj) { const int Lu = lb[q][sl] + (2 * jj + (lane >> 5)) * lt[q][sl];
                                    if (Lu >= tF) { float a8[8] = {0.f, 0.f, 0.f, 0.f, 0.f, 0.f, 0.f, 0.f};
                                        const bf16* sp_ = Y2 + ((size_t)((Lu - tF) * tsp) * 256 + rit[q][sl]) * 256 + 8 * (lane & 31);
                                        for (int p = 0; p < tsp; ++p) { const v4u t = *(const v4u*)(sp_ + (size_t)p * 65536);
                                            a8[0] += bflo(t.x); a8[1] += bfhi(t.x); a8[2] += bflo(t.y); a8[3] += bfhi(t.y); a8[4] += bflo(t.z); a8[5] += bfhi(t.z); a8[6] += bflo(t.w); a8[7] += bfhi(t.w); }
                                        v4u pk; pk.x = pk2(a8[0], a8[1]); pk.y = pk2(a8[2], a8[3]); pk.z = pk2(a8[4], a8[5]); pk.w = pk2(a8[6], a8[7]);
                                        ya[q][jj][2 * sl] = (v4u){0u, 0u, 0u, 0u}; ya[q][jj][2 * sl + 1] = pk; } }
                    }
#pragma unroll
                    for (int q = 0; q < 2; ++q) { float s = 0.f;
#pragma unroll
                        for (int jj = 0; jj < 4; ++jj) { const v4u a1 = ya[q][jj][0], b1 = ya[q][jj][1], a2 = ya[q][jj][2], b2 = ya[q][jj][3]; const float u1 = w1[q], u2 = w2[q];
                            f32x4 m0, m1;
                            m0.x = u1 * (bflo(a1.x) + bflo(b1.x)) + u2 * (bflo(a2.x) + bflo(b2.x)); m0.y = u1 * (bfhi(a1.x) + bfhi(b1.x)) + u2 * (bfhi(a2.x) + bfhi(b2.x));
                            m0.z = u1 * (bflo(a1.y) + bflo(b1.y)) + u2 * (bflo(a2.y) + bflo(b2.y)); m0.w = u1 * (bfhi(a1.y) + bfhi(b1.y)) + u2 * (bfhi(a2.y) + bfhi(b2.y));
                            m1.x = u1 * (bflo(a1.z) + bflo(b1.z)) + u2 * (bflo(a2.z) + bflo(b2.z)); m1.y = u1 * (bfhi(a1.z) + bfhi(b1.z)) + u2 * (bfhi(a2.z) + bfhi(b2.z));
                            m1.z = u1 * (bflo(a1.w) + bflo(b1.w)) + u2 * (bflo(a2.w) + bflo(b2.w)); m1.w = u1 * (bfhi(a1.w) + bfhi(b1.w)) + u2 * (bfhi(a2.w) + bfhi(b2.w));
                            v[q][2 * jj] += m0; v[q][2 * jj + 1] += m1; }
#pragma unroll
                        for (int j = 0; j < 8; ++j) s += (v[q][j].x * v[q][j].x + v[q][j].y * v[q][j].y) + (v[q][j].z * v[q][j].z + v[q][j].w * v[q][j].w);
                        const float rstd = 1.0f / sqrtf(wave_sum(s) * (1.f / D) + RMS_EPS);
                        if (q == 0 || (t0 + NGW) < M) { f32x4* orow = (f32x4*)(out + (size_t)tk[q] * D) + 2 * lane;
#pragma unroll
                            for (int jj = 0; jj < 4; ++jj)
#pragma unroll
                                for (int hf = 0; hf < 2; ++hf) { const f32x4 g = gr[128 * jj + hf]; const f32x4 x = v[q][2 * jj + hf]; f32x4 o; o.x = x.x * rstd * g.x; o.y = x.y * rstd * g.y; o.z = x.z * rstd * g.z; o.w = x.w * rstd * g.w; orow[128 * jj + hf] = o; } } }
                }
            }
        }
}

__global__ void __launch_bounds__(NWAVES * 64, 2) fwd_kernel(Args args_unused) {
    extern __shared__ __attribute__((aligned(16))) unsigned char lds_raw[];
    LAS unsigned char* lds = (LAS unsigned char*)lds_raw;
    volatile LAS unsigned* MISC = (volatile LAS unsigned*)(lds + MISC_OFF);
    const int tid0 = threadIdx.x, wave0 = __builtin_amdgcn_readfirstlane(tid0 >> 6);
    const int G = gridDim.x; const int bx = blockIdx.x;
    const int vcu = (G % 8 == 0) ? (bx % 8) * (G / 8) + bx / 8 : bx;
    const int gw0 = vcu * NWAVES + wave0, NGW = G * NWAVES;
    for (int u = tid0; u < (LDS_BYTES - LDSCTL_OFF) / 4; u += NWAVES * 64) ((LAS unsigned*)(lds + LDSCTL_OFF))[u] = 0u;
    __syncthreads();
#if MK_PER_PHASE
    XcdBarrier bar; bar.bar = nullptr; bar.x = 0; bar.st = nullptr;
#else
    XcdBarrier bar = xcd_barrier_post((unsigned*)(argp()->ws + WS_CTL) + CW_BAR, MISC + 8);
#endif
#if MK_PER_PHASE
    const int lo = argp()->ph_lo, hi = argp()->ph_hi;
#else
    constexpr int lo = 0, hi = NPH;
#endif

    if (IN(0)) {
        ArgsP A = argp(); PH_LOCALS();
        constexpr int NBAL = N_STRIPS % 256, BAL_TILES = (256 - NBAL) * 16;
        if (G == 256 && PROJ_STGB > 0 && STRIPS_HOSTED) {
            strips_to_i8(A, lds + RING_OFF, bx, G, wave, lane, STRIPS_WIN);
            cvt_range_big(A, SEG_D0 + 2 * POOL_CVT + 2 * PROJ_CVT + FGU_CVT, SEG_D0 + 2 * POOL_CVT + 2 * PROJ_CVT + FGU_CVT + BAL_TILES, gw, NGW, lane);
        } else {
        strips_to_i8(A, lds + RING_OFF, bx, G, wave, lane);
        if (G == 256 && bx >= NBAL) cvt_range_big(A, SEG_D0 + 2 * POOL_CVT + 2 * PROJ_CVT + FGU_CVT, SEG_D0 + 2 * POOL_CVT + 2 * PROJ_CVT + FGU_CVT + BAL_TILES, (bx - NBAL) * NWAVES + wave, (256 - NBAL) * NWAVES, lane);
        }
        if (!(G == 256 && PROJ_STGB > 0)) {
        cvt_range(A, SEG_A0 + T_WIN, SEG_B0, gw, NGW, lane);
        cvt_range(A, SEG_B0 + 2 * T_FF8, SEG_C0, gw, NGW, lane); }
        if (G != 256) cvt_range(A, SEG_C0 + T_WIN, SEG_D0, gw, NGW, lane);
        cvt_range_big(A, G == 256 ? HK_DEND : SEG_D0, SEG_E0, gw, NGW, lane);
        const float* x = A->in[0]; const float* gn = A->in[1];
        for (int m = gw; m < M; m += 4 * NGW) rms_rows_to_i8<4>(x, gn, WSP(unsigned char, WS_H), WSP(float, WS_TOK + 262144), m, NGW, lane);
    }
    SEAM(0);

    layer_phases<0>(lds, G, bx, vcu, gw0, wave0, NGW, lo, hi, bar);
    layer_phases<1>(lds, G, bx, vcu, gw0, wave0, NGW, lo, hi, bar);
#undef IN
#undef SEAM
#undef WSP
}

extern "C" void kernel_launch(void* const* d_in, const int* in_sizes, int n_in, void* d_out, int out_size, void* d_ws, size_t ws_size, hipStream_t stream) {
    static int grid = 0;
    if (grid == 0) {
        if (n_in != 17 || out_size != M * D || ws_size < WS_END) { fprintf(stderr, "kernel_launch: unexpected shapes (n_in %d out %d ws %zu)\n", n_in, out_size, ws_size); grid = -1; return; }
        int dev = 0, cus = 0, per_cu = 0;
        if (hipGetDevice(&dev) != hipSuccess || hipDeviceGetAttribute(&cus, hipDeviceAttributeMultiprocessorCount, dev) != hipSuccess) { grid = -1; return; }
        if (hipFuncSetAttribute((const void*)fwd_kernel, hipFuncAttributeMaxDynamicSharedMemorySize, LDS_BYTES) != hipSuccess) { fprintf(stderr, "kernel_launch: hipFuncSetAttribute failed\n"); grid = -1; return; }
        if (hipOccupancyMaxActiveBlocksPerMultiprocessor(&per_cu, (const void*)fwd_kernel, NWAVES * 64, LDS_BYTES) != hipSuccess || per_cu < 1) fprintf(stderr, "kernel_launch: occupancy query reports %d\n", per_cu);
        (void)hipGetLastError();
        grid = cus;
    }
    if (grid < 0) return;
    (void)hipMemsetAsync((char*)d_ws + WS_CTL, 0, CTL_ZERO_BYTES, stream);
    Args a{};
    for (int i = 0; i < 17; ++i) a.in[i] = (const float*)d_in[i];
    a.out = (float*)d_out; a.ws = (unsigned char*)d_ws;
#if MK_PER_PHASE
    for (int p = 0; p < NPH; ++p) { a.ph_lo = p; a.ph_hi = p + 1; hipLaunchKernelGGL(fwd_kernel, dim3(grid), dim3(NWAVES * 64), LDS_BYTES, stream, a); }
#else
    a.ph_lo = 0; a.ph_hi = NPH; hipLaunchKernelGGL(fwd_kernel, dim3(grid), dim3(NWAVES * 64), LDS_BYTES, stream, a);
#endif
}
```

```cpp
#include <hip/hip_runtime.h>
#include <cstdio>
#include <cstdint>

#ifndef PROBE_DUP
#define HK_TPU 4
#define MOE_STG 11264
#define DENSE_DOWN_FP8 1
#define STG_MASK 9
#define HK_MASK 0
#define PROBE_DUP 0
#endif
#ifndef MK_PER_PHASE
#define MK_PER_PHASE 0
#endif

namespace pg8 {
#define PG8_LAS __attribute__((address_space(3)))
typedef unsigned short bf16_t;
typedef short bf16x8 __attribute__((ext_vector_type(8)));
typedef float f32x4 __attribute__((ext_vector_type(4)));
typedef float f32x2 __attribute__((ext_vector_type(2)));
typedef unsigned u32x4 __attribute__((ext_vector_type(4)));
typedef unsigned u32x2 __attribute__((ext_vector_type(2)));
typedef int i32x4 __attribute__((ext_vector_type(4)));
typedef int i32x8 __attribute__((ext_vector_type(8)));
constexpr int BM = 256, BK = 64, HALF = 128, HTB = HALF * BK * 2, STAGE_BYTES = 8 * HTB, NXCD = 8, WGM = 8;

__device__ __forceinline__ int lane_id_now() { int l; asm volatile("v_mbcnt_lo_u32_b32 %0, -1, 0\n\tv_mbcnt_hi_u32_b32 %0, -1, %0" : "=v"(l)); return l; }
__host__ __device__ __forceinline__ int lds_byte(int r, int c) { const int st = (r >> 4) * 2 + (c >> 5), rr = r & 15, cc = c & 31, ob = rr * 64 + cc * 2; return st * 1024 + (ob ^ (((ob >> 9) & 1) << 5)); }
__host__ __device__ __forceinline__ void stage_rc(int b, int& R, int& C) { const int st = b / 1024, sb = b % 1024, swz = sb ^ (((sb >> 9) & 1) << 5); R = (st >> 1) * 16 + swz / 64; C = (st & 1) * 32 + (swz % 64) / 2; }
__host__ __device__ __forceinline__ int perm32(int rho) { const int n = rho >> 4, i = rho & 15; return 8 * (i >> 2) + 4 * n + (i & 3); }

struct Unit { int pm, pn; size_t aoff, boff; int nkt, part, gbase; };

template <int NM, int NN, int LDA, int LDB, int APN> struct StaticOrder {
    int G, c;
    __device__ __forceinline__ bool next(int i, Unit& u) const {
        constexpr int nwg = NM * NN;
        const int L = i * G + c; if (L >= nwg) return false;
        int wgid = L; { constexpr int q = nwg / NXCD, r = nwg % NXCD; const int xcd = wgid % NXCD, off = wgid / NXCD; wgid = (xcd < r ? xcd * (q + 1) : r * (q + 1) + (xcd - r) * q) + off; }
        constexpr int nig = WGM * NN; const int gid = wgid / nig, fm = gid * WGM, gsz = (NM - fm) < WGM ? (NM - fm) : WGM;
        u.pm = fm + ((wgid % nig) % gsz); u.pn = (wgid % nig) / gsz;
        u.aoff = (size_t)u.pm * ((size_t)BM * LDA * 2) + (size_t)u.pn * APN; u.boff = (size_t)u.pn * ((size_t)BM * LDB * 2); return true;
    }
};
template <int NN, int LDA, int LDB, size_t BEXP> struct MoeOrder {
    int G, c; int ts[9]; const int* inv;
    __device__ __forceinline__ bool next(int i, Unit& u) const {
        const int L = i * G + c; if (L >= ts[8] * NN) return false;
        int e = 0, s0 = ts[0], s1 = ts[1];
#pragma unroll
        for (int j = 1; j < 8; ++j) if (L >= ts[j] * NN) { e = j; s0 = ts[j]; s1 = ts[j + 1]; }
        const int Le = L - s0 * NN, tc = s1 - s0, pn = Le / tc, tm = Le - pn * tc;
        u.pm = s0 + tm; u.pn = pn; u.aoff = (size_t)u.pm * ((size_t)BM * LDA * 2); u.boff = (size_t)e * BEXP + (size_t)pn * ((size_t)BM * LDB * 2); u.gbase = e * 8192 + tm * BM; return true;
    }
};

template <int NN, int LDA, int LDB, int KP, size_t BEXP, int KS = 2> struct SplitKOrder {
    int G, c; int ts[9];
    __device__ __forceinline__ bool next(int i, Unit& u) const {
        const int U = ts[8] * NN; int L = i * G + c; if (L >= KS * U) return false;
        const int part = (KS == 2 && L >= U) ? 1 : 0; L -= part * U;
        int e = 0, s0 = ts[0], s1 = ts[1];
#pragma unroll
        for (int j = 1; j < 8; ++j) if (L >= ts[j] * NN) { e = j; s0 = ts[j]; s1 = ts[j + 1]; }
        const int Le = L - s0 * NN, tc = s1 - s0, pn = Le / tc, tm = Le - pn * tc;
        constexpr int KH = KP / KS;
        u.pm = s0 + tm; u.pn = pn; u.nkt = 2 * KH; u.part = part;
        u.aoff = (size_t)u.pm * ((size_t)BM * LDA * 2) + (size_t)part * KH * 256; u.boff = (size_t)e * BEXP + (size_t)pn * ((size_t)BM * LDB * 2) + (size_t)part * KH * 256; return true;
    }
};

constexpr int TAIL_MAX_SPLIT = 8;
template <int NN, int LDA, int LDB, int KP, size_t BEXP> struct TailSplitOrder {
    int G, c; int ts[9];
    __device__ __forceinline__ void tail_split(int& F, int& R, int& sp) const { const int U = ts[8] * NN; F = (U / G) * G; R = U - F; sp = R > 0 ? G / R : 1; sp = sp > TAIL_MAX_SPLIT ? TAIL_MAX_SPLIT : sp; }
    __device__ __forceinline__ bool next(int i, Unit& u) const {
        int F, R, sp; tail_split(F, R, sp);
        int L, kp0 = 0, kpn = KP, part = 0;
        if (i * G < F) L = i * G + c;
        else if (i * G == F && R > 0) { if (c >= R * sp) return false; const int r = c % R, p = c / R; L = F + r; kp0 = (p * KP) / sp; kpn = ((p + 1) * KP) / sp - kp0; part = sp > 1 ? 1 + r * sp + p : 0; }
        else return false;
        int e = 0, s0 = ts[0], s1 = ts[1];
#pragma unroll
        for (int j = 1; j < 8; ++j) if (L >= ts[j] * NN) { e = j; s0 = ts[j]; s1 = ts[j + 1]; }
        const int Le = L - s0 * NN, tc = s1 - s0, pn = Le / tc, tm = Le - pn * tc;
        u.pm = s0 + tm; u.pn = pn; u.nkt = 2 * kpn; u.part = part;
        u.aoff = (size_t)u.pm * ((size_t)BM * LDA * 2) + (size_t)kp0 * 256; u.boff = (size_t)e * BEXP + (size_t)pn * ((size_t)BM * LDB * 2) + (size_t)kp0 * 256; return true;
    }
};

__device__ __forceinline__ unsigned cvt_pk_bf16(float lo, float hi) { unsigned r; asm volatile("v_cvt_pk_bf16_f32 %0, %1, %2" : "=v"(r) : "v"(lo), "v"(hi)); return r; }
__device__ __forceinline__ float bf_lo(unsigned w) { return __uint_as_float(w << 16); }
__device__ __forceinline__ float bf_hi(unsigned w) { return __uint_as_float(w & 0xffff0000u); }
__device__ __forceinline__ float sigmoidf_(float x) { return __builtin_amdgcn_rcpf(1.0f + __builtin_amdgcn_exp2f(-1.4426950408889634f * x)); }

struct EpiProj {
    static constexpr bool PERM = true; static constexpr bool PRE = true;
    bf16_t *upool, *q, *k2, *v3, *gates; const float* rowscale; const unsigned* colmax;
    struct Pre { u32x4 cm[2][2]; float rs[2][4]; };
    __device__ __forceinline__ void pre(const Unit& u, int wr, int wc, Pre& P) const {
        const int lane_ = lane_id_now(); const int fr = lane_ & 15, fq = lane_ >> 4;
#pragma unroll
        for (int bj = 0; bj < 2; ++bj)
#pragma unroll
            for (int n = 0; n < 2; ++n) P.cm[bj][n] = *(const u32x4*)(colmax + u.pn * BM + bj * HALF + wc * 32 + 8 * fq + 4 * n);
#pragma unroll
        for (int ai = 0; ai < 2; ++ai)
#pragma unroll
            for (int m = 0; m < 4; ++m) P.rs[ai][m] = rowscale[u.pm * BM + wr * 64 + fr + ai * HALF + m * 16];
    }
    __device__ __forceinline__ void operator()(const f32x4 (&acc_in)[2][2][4][2], const Unit& u, int wr, int wc, const Pre& P) const {
        const int lane_ = lane_id_now(); const int fr = lane_ & 15, fq = lane_ >> 4;
        const int pn = u.pn, row0 = u.pm * BM + wr * 64 + fr;
        f32x4 acc[2][2][4][2];
        { f32x4 cs[2][2];
#pragma unroll
          for (int bj = 0; bj < 2; ++bj)
#pragma unroll
              for (int n = 0; n < 2; ++n) { const u32x4 a = P.cm[bj][n];
#pragma unroll
                  for (int e = 0; e < 4; ++e) cs[bj][n][e] = __uint_as_float(a[e]) * (pn >= 16 ? -1.4426950408889634f / 127.0f : 1.0f / 127.0f); }
#pragma unroll
          for (int ai = 0; ai < 2; ++ai)
#pragma unroll
              for (int m = 0; m < 4; ++m) { const float rs = P.rs[ai][m];
#pragma unroll
                  for (int bj = 0; bj < 2; ++bj)
#pragma unroll
                      for (int n = 0; n < 2; ++n)
#pragma unroll
                          for (int e = 0; e < 4; ++e) acc[ai][bj][m][n][e] = (float)__float_as_int(acc_in[ai][bj][m][n][e]) * (rs * cs[bj][n][e]); } }
        if (pn >= 12 && pn < 16) {
            const int jj = 4 * (fr >> 3) + (fr & 3), hh = (fr >> 2) & 1;
#pragma unroll
            for (int ai = 0; ai < 2; ++ai)
#pragma unroll
                for (int m = 0; m < 4; ++m) { const int row = row0 + ai * HALF + m * 16, b = row >> 12, kb = (row & 4095) >> 5, s = m & 1;
#pragma unroll
                    for (int bj = 0; bj < 2; ++bj) { const int h = 2 * (pn - 12) + bj;
                        bf16_t* vp = v3 + ((size_t)((((((b * 8 + h) * 128 + kb) * 4 + wc) * 2 + s) * 2 + hh) * 32 + 8 * fq) * 8 + jj);
#pragma unroll
                        for (int n = 0; n < 2; ++n)
#pragma unroll
                            for (int e = 0; e < 4; e += 2) { const unsigned w = cvt_pk_bf16(acc[ai][bj][m][n][e], acc[ai][bj][m][n][e + 1]);
                                vp[(4 * n + e) * 8] = (bf16_t)(w & 0xffffu); vp[(4 * n + e + 1) * 8] = (bf16_t)(w >> 16); } } }
            return;
        }
        if (pn >= 8 && pn < 12) {
#pragma unroll
            for (int ai = 0; ai < 2; ++ai)
#pragma unroll
                for (int m = 0; m < 4; ++m) { const int row = row0 + ai * HALF + m * 16, b = row >> 12, kb = (row & 4095) >> 5, r = row & 31;
#pragma unroll
                    for (int bj = 0; bj < 2; ++bj) { const int h = 2 * (pn - 8) + bj, s = 2 * wc + (fq >> 1), hh = fq & 1;
                        const f32x4 v0 = acc[ai][bj][m][0], v1 = acc[ai][bj][m][1];
                        u32x4 w; w.x = cvt_pk_bf16(v0[0], v0[1]); w.y = cvt_pk_bf16(v0[2], v0[3]); w.z = cvt_pk_bf16(v1[0], v1[1]); w.w = cvt_pk_bf16(v1[2], v1[3]);
                        *(u32x4*)(k2 + ((size_t)(((((b * 8 + h) * 128 + kb) * 8 + s) * 2 + hh) * 32 + r) * 8)) = w; } }
            return;
        }
        bf16_t* base; int ldc, colt; bool sig = false;
        if (pn < 4) { base = upool; ldc = 1024; colt = pn * BM; }
        else if (pn < 8) { base = q; ldc = 1024; colt = (pn - 4) * BM; }
        else { base = gates; ldc = 4096; colt = (pn - 16) * BM; sig = true; }
#pragma unroll
        for (int ai = 0; ai < 2; ++ai)
#pragma unroll
            for (int m = 0; m < 4; ++m) { bf16_t* rowp = base + (size_t)(row0 + ai * HALF + m * 16) * ldc + colt + wc * 32 + 8 * fq;
#pragma unroll
                for (int bj = 0; bj < 2; ++bj) { f32x4 v0 = acc[ai][bj][m][0], v1 = acc[ai][bj][m][1];
                    if (sig) {
#pragma unroll
                        for (int e = 0; e < 4; ++e) { v0[e] = __builtin_amdgcn_rcpf(1.0f + __builtin_amdgcn_exp2f(v0[e])); v1[e] = __builtin_amdgcn_rcpf(1.0f + __builtin_amdgcn_exp2f(v1[e])); } }
                    u32x4 w; w.x = cvt_pk_bf16(v0[0], v0[1]); w.y = cvt_pk_bf16(v0[2], v0[3]); w.z = cvt_pk_bf16(v1[0], v1[1]); w.w = cvt_pk_bf16(v1[2], v1[3]);
                    *(u32x4*)(rowp + bj * HALF) = w; } }
    }
};
struct EpiPool {
    static constexpr bool PERM = true; static constexpr bool PRE = false;
    bf16_t* O; const float* scale;
    __device__ __forceinline__ void operator()(const f32x4 (&acc)[2][2][4][2], const Unit& u, int wr, int wc) const {
        const int lane_ = lane_id_now(); const int fr = lane_ & 15, fq = lane_ >> 4;
        const int row0 = u.pm * BM + wr * 64 + fr, col0 = u.pn * BM + wc * 32 + 8 * fq;
#pragma unroll
        for (int bj = 0; bj < 2; ++bj) { const f32x4 s0 = *(const f32x4*)(scale + col0 + bj * HALF), s1 = *(const f32x4*)(scale + col0 + bj * HALF + 4);
#pragma unroll
            for (int ai = 0; ai < 2; ++ai)
#pragma unroll
                for (int m = 0; m < 4; ++m) { bf16_t* rowp = O + (size_t)(row0 + ai * HALF + m * 16) * 1024 + col0;
                    const f32x4 v0 = acc[ai][bj][m][0] * s0, v1 = acc[ai][bj][m][1] * s1;
                    u32x4 w; w.x = cvt_pk_bf16(v0[0], v0[1]); w.y = cvt_pk_bf16(v0[2], v0[3]); w.z = cvt_pk_bf16(v1[0], v1[1]); w.w = cvt_pk_bf16(v1[2], v1[3]);
                    *(u32x4*)(rowp + bj * HALF) = w; }
            asm volatile("" ::: "memory"); }
    }
};
template <int STEP> struct EpiGate {
    static constexpr bool PERM = true; static constexpr bool PRE = false;
    const bf16_t* gates; bf16_t* T; bf16_t* O;
    __device__ __forceinline__ void operator()(const f32x4 (&acc)[2][2][4][2], const Unit& u, int wr, int wc) const {
        const int lane_ = lane_id_now(); const int fr = lane_ & 15, fq = lane_ >> 4;
        const int row0 = u.pm * BM + wr * 64 + fr, col0 = u.pn * BM + wc * 32 + 8 * fq;
#pragma unroll
        for (int ai = 0; ai < 2; ++ai) {
            u32x4 gv[4][2], tv[4][2];
#pragma unroll
            for (int m = 0; m < 4; ++m)
#pragma unroll
                for (int bj = 0; bj < 2; ++bj) { const size_t row = (size_t)(row0 + ai * HALF + m * 16); const int col = col0 + bj * HALF;
                    gv[m][bj] = *(const u32x4*)(gates + row * 4096 + (STEP == 1 ? 0 : 2048) + col);
                    if (STEP == 2) tv[m][bj] = *(const u32x4*)(T + row * 2048 + col); }
#pragma unroll
            for (int m = 0; m < 4; ++m)
#pragma unroll
                for (int bj = 0; bj < 2; ++bj) { const size_t row = (size_t)(row0 + ai * HALF + m * 16); const int col = col0 + bj * HALF;
                    const u32x4 g = gv[m][bj];
                    f32x4 v0 = acc[ai][bj][m][0], v1 = acc[ai][bj][m][1];
                    v0[0] *= bf_lo(g.x); v0[1] *= bf_hi(g.x); v0[2] *= bf_lo(g.y); v0[3] *= bf_hi(g.y); v1[0] *= bf_lo(g.z); v1[1] *= bf_hi(g.z); v1[2] *= bf_lo(g.w); v1[3] *= bf_hi(g.w);
                    if (STEP == 2) { const u32x4 t = tv[m][bj];
                        v0[0] += bf_lo(t.x); v0[1] += bf_hi(t.x); v0[2] += bf_lo(t.y); v0[3] += bf_hi(t.y); v1[0] += bf_lo(t.z); v1[1] += bf_hi(t.z); v1[2] += bf_lo(t.w); v1[3] += bf_hi(t.w); }
                    u32x4 w; w.x = cvt_pk_bf16(v0[0], v0[1]); w.y = cvt_pk_bf16(v0[2], v0[3]); w.z = cvt_pk_bf16(v1[0], v1[1]); w.w = cvt_pk_bf16(v1[2], v1[3]);
                    *(u32x4*)((STEP == 1 ? T : O) + row * 2048 + col) = w; }
            asm volatile("" ::: "memory");
        }
    }
};
struct EpiResid {
    static constexpr bool PERM = false; static constexpr bool PRE = false;
    const float* base; float* out; float sc;
    __device__ __forceinline__ void operator()(const f32x4 (&acc)[2][2][4][2], const Unit& u, int wr, int wc) const {
        const int lane_ = lane_id_now(); const int fr = lane_ & 15, fq = lane_ >> 4;
        const int row0 = u.pm * BM + wr * 64 + fr, col0 = u.pn * BM + wc * 32 + 4 * fq;
#pragma unroll
        for (int ai = 0; ai < 2; ++ai)
#pragma unroll
            for (int mp = 0; mp < 2; ++mp) {
                f32x4 bv[2][2][2];
#pragma unroll
                for (int mm = 0; mm < 2; ++mm) { const size_t off = (size_t)(row0 + ai * HALF + (2 * mp + mm) * 16) * 2048 + col0;
#pragma unroll
                    for (int bj = 0; bj < 2; ++bj)
#pragma unroll
                        for (int n = 0; n < 2; ++n) bv[mm][bj][n] = base ? *(const f32x4*)(base + off + bj * HALF + n * 16) : (f32x4){0.f, 0.f, 0.f, 0.f}; }
#pragma unroll
                for (int mm = 0; mm < 2; ++mm) { const size_t off = (size_t)(row0 + ai * HALF + (2 * mp + mm) * 16) * 2048 + col0;
#pragma unroll
                    for (int bj = 0; bj < 2; ++bj)
#pragma unroll
                        for (int n = 0; n < 2; ++n) *(f32x4*)(out + off + bj * HALF + n * 16) = acc[ai][bj][2 * mp + mm][n] * sc + bv[mm][bj][n]; }
                asm volatile("" ::: "memory");
            }
    }
};
struct EpiPart {
    static constexpr bool PERM = true; static constexpr bool PRE = false;
    bf16_t* y0; bf16_t* y1; float sc;
    __device__ __forceinline__ void operator()(const f32x4 (&acc)[2][2][4][2], const Unit& u, int wr, int wc) const {
        const int lane_ = lane_id_now(); const int fr = lane_ & 15, fq = lane_ >> 4;
        bf16_t* out = u.part ? y1 + (size_t)(u.part - 1) * 65536 : y0; const int ldc = u.part ? 256 : 2048;
        const int row0 = (u.part ? 0 : u.pm * BM) + wr * 64 + fr, col0 = (u.part ? 0 : u.pn * BM) + wc * 32 + 8 * fq;
#pragma unroll
        for (int ai = 0; ai < 2; ++ai)
#pragma unroll
            for (int m = 0; m < 4; ++m) { bf16_t* rowp = out + (size_t)(row0 + ai * HALF + m * 16) * ldc + col0;
#pragma unroll
                for (int bj = 0; bj < 2; ++bj) { const f32x4 v0 = acc[ai][bj][m][0] * sc, v1 = acc[ai][bj][m][1] * sc;
                    u32x4 w; w.x = cvt_pk_bf16(v0[0], v0[1]); w.y = cvt_pk_bf16(v0[2], v0[3]); w.z = cvt_pk_bf16(v1[0], v1[1]); w.w = cvt_pk_bf16(v1[2], v1[3]);
                    *(u32x4*)(rowp + bj * HALF) = w; } }
    }
};
__device__ __forceinline__ unsigned pk4_fp8(float a, float b, float c, float d) {
    float hi = 448.f; asm volatile("" : "+s"(hi));
    a = __builtin_amdgcn_fmed3f(a, -hi, hi); b = __builtin_amdgcn_fmed3f(b, -hi, hi); c = __builtin_amdgcn_fmed3f(c, -hi, hi); d = __builtin_amdgcn_fmed3f(d, -hi, hi);
    int w = 0; w = __builtin_amdgcn_cvt_pk_fp8_f32(a, b, w, false); w = __builtin_amdgcn_cvt_pk_fp8_f32(c, d, w, true); return (unsigned)w;
}
constexpr float FP8_W_SCALE = 128.f, FP8_H_SCALE = 8.f, FP8_G_SCALE = 4.f;
struct EpiSwiGLU8 {
    static constexpr bool PERM = true; static constexpr bool PRE = false;
    unsigned char* G;
    __device__ __forceinline__ void operator()(const f32x4 (&acc)[2][2][4][2], const Unit& u, int wr, int wc) const {
        const int lane_ = lane_id_now(); const int fr = lane_ & 15, fq = lane_ >> 4;
        const int row0 = u.pm * BM + wr * 64 + fr, col0 = u.pn * HALF + wc * 32 + 8 * fq;
        constexpr float inv = 1.0f / (FP8_W_SCALE * FP8_H_SCALE), k1 = -1.4426950408889634f * inv, k2 = inv * inv * FP8_G_SCALE;
#pragma unroll
        for (int ai = 0; ai < 2; ++ai)
#pragma unroll
            for (int m = 0; m < 4; ++m) { unsigned char* rowp = G + (size_t)(row0 + ai * HALF + m * 16) * 5632 + col0;
                f32x4 v[2];
#pragma unroll
                for (int n = 0; n < 2; ++n)
#pragma unroll
                    for (int e = 0; e < 4; ++e) { const float ag = acc[ai][0][m][n][e], au = acc[ai][1][m][n][e];
                        v[n][e] = (ag * au) * (__builtin_amdgcn_rcpf(1.0f + __builtin_amdgcn_exp2f(ag * k1)) * k2); }
                u32x2 w; w.x = pk4_fp8(v[0][0], v[0][1], v[0][2], v[0][3]); w.y = pk4_fp8(v[1][0], v[1][1], v[1][2], v[1][3]);
                *(u32x2*)rowp = w; }
    }
};
struct EpiSwiGLUi8 {
    static constexpr bool PERM = true; static constexpr bool PRE = true;
    bf16_t* G; const float* rowscale; const unsigned* colmax;
    struct Pre { u32x4 cm[2][2]; float rs[2][4]; };
    __device__ __forceinline__ void pre(const Unit& u, int wr, int wc, Pre& P) const {
        const int lane_ = lane_id_now(); const int fr = lane_ & 15, fq = lane_ >> 4; const int col0 = u.pn * HALF + wc * 32 + 8 * fq;
#pragma unroll
        for (int n = 0; n < 2; ++n) { P.cm[0][n] = *(const u32x4*)(colmax + col0 + 4 * n); P.cm[1][n] = *(const u32x4*)(colmax + 5632 + col0 + 4 * n); }
#pragma unroll
        for (int ai = 0; ai < 2; ++ai)
#pragma unroll
            for (int m = 0; m < 4; ++m) P.rs[ai][m] = rowscale[u.pm * BM + wr * 64 + fr + ai * HALF + m * 16];
    }
    __device__ __forceinline__ void operator()(const f32x4 (&acc)[2][2][4][2], const Unit& u, int wr, int wc, const Pre& P) const {
        const int lane_ = lane_id_now(); const int fr = lane_ & 15, fq = lane_ >> 4;
        const int row0 = u.pm * BM + wr * 64 + fr, col0 = u.pn * HALF + wc * 32 + 8 * fq;
        f32x4 cg[2], cu[2];
#pragma unroll
        for (int n = 0; n < 2; ++n) { const u32x4 a = P.cm[0][n], b = P.cm[1][n];
#pragma unroll
            for (int e = 0; e < 4; ++e) { cg[n][e] = __uint_as_float(a[e]) * (1.0f / 127.0f); cu[n][e] = __uint_as_float(b[e]) * (1.0f / 127.0f); } }
#pragma unroll
        for (int ai = 0; ai < 2; ++ai)
#pragma unroll
            for (int m = 0; m < 4; ++m) { const int row = row0 + ai * HALF + m * 16; const float rs = P.rs[ai][m]; bf16_t* rowp = G + (size_t)row * 5632 + col0; unsigned char* rowp8 = (unsigned char*)G + (size_t)row * 5632 + col0;
                f32x4 v[2];
#pragma unroll
                for (int n = 0; n < 2; ++n)
#pragma unroll
                    for (int e = 0; e < 4; ++e) { const float g = (float)__float_as_int(acc[ai][0][m][n][e]) * (rs * cg[n][e]), up = (float)__float_as_int(acc[ai][1][m][n][e]) * (rs * cu[n][e]); v[n][e] = g * sigmoidf_(g) * up; }
                if (DENSE_DOWN_FP8) { u32x2 w8; w8.x = pk4_fp8(v[0][0] * FP8_G_SCALE, v[0][1] * FP8_G_SCALE, v[0][2] * FP8_G_SCALE, v[0][3] * FP8_G_SCALE); w8.y = pk4_fp8(v[1][0] * FP8_G_SCALE, v[1][1] * FP8_G_SCALE, v[1][2] * FP8_G_SCALE, v[1][3] * FP8_G_SCALE);
                    *(u32x2*)rowp8 = w8; }
                else {
                u32x4 w; w.x = cvt_pk_bf16(v[0][0], v[0][1]); w.y = cvt_pk_bf16(v[0][2], v[0][3]); w.z = cvt_pk_bf16(v[1][0], v[1][1]); w.w = cvt_pk_bf16(v[1][2], v[1][3]);
                *(u32x4*)rowp = w; } }
    }
};
struct EpiSwiGLU {
    static constexpr bool PERM = true; static constexpr bool PRE = false;
    bf16_t* G;
    __device__ __forceinline__ void operator()(const f32x4 (&acc)[2][2][4][2], const Unit& u, int wr, int wc) const {
        const int lane_ = lane_id_now(); const int fr = lane_ & 15, fq = lane_ >> 4;
        const int row0 = u.pm * BM + wr * 64 + fr, col0 = u.pn * HALF + wc * 32 + 8 * fq;
#pragma unroll
        for (int ai = 0; ai < 2; ++ai)
#pragma unroll
            for (int m = 0; m < 4; ++m) { bf16_t* rowp = G + (size_t)(row0 + ai * HALF + m * 16) * 5632 + col0;
                f32x4 v[2];
#pragma unroll
                for (int n = 0; n < 2; ++n)
#pragma unroll
                    for (int e = 0; e < 4; ++e) { const float g = acc[ai][0][m][n][e], up = acc[ai][1][m][n][e]; v[n][e] = g * sigmoidf_(g) * up; }
                u32x4 w; w.x = cvt_pk_bf16(v[0][0], v[0][1]); w.y = cvt_pk_bf16(v[0][2], v[0][3]); w.z = cvt_pk_bf16(v[1][0], v[1][1]); w.w = cvt_pk_bf16(v[1][2], v[1][3]);
                *(u32x4*)rowp = w; }
    }
};

struct NoHook { static constexpr bool ON = false; struct Regs {}; };
template <class E, bool P = E::PRE> struct PreOf { struct type {}; };
template <class E> struct PreOf<E, true> { using type = typename E::Pre; };
template <int LDA, int LDB, int KDIM, class Epi, class Sched, bool ALIGN_EPI = true, bool VARK = false, int FP8 = 0  , bool GATH = false  , class Hook = NoHook  >
__device__ __forceinline__ void gemm_phase(PG8_LAS unsigned char* lds, const bf16_t* gA, const bf16_t* gBt, const Sched& S, const Epi& E, int wid_in, const Hook& HK = Hook()) {
    const int lane = lane_id_now();
    const int wid = wid_in, tid = wid * 64 + lane, wr = wid >> 2, wc = wid & 3, fr = lane & 15, fq = lane >> 4;
    constexpr int nt = KDIM / BK;
    unsigned voffA[2], voffB[2];
#pragma unroll
    for (int i = 0; i < 2; ++i) { int R, C; stage_rc(tid * 16 + i * 8192, R, C); const int Rb = Epi::PERM ? ((R & ~31) + perm32(R & 31)) : R;
        voffA[i] = (unsigned)(R * LDA + C) * 2u; voffB[i] = (unsigned)(Rb * LDB + C) * 2u; }
    constexpr size_t kstep = (size_t)(BK * 2);
    constexpr size_t hstepA = (size_t)HALF * LDA * 2, hstepB = (size_t)HALF * LDB * 2;
    const unsigned ldsw = (unsigned)wid * 1024u, ldsb = (unsigned)(size_t)lds;
    const int aoff = lds_byte(wr * 64 + fr, fq * 8), boff = lds_byte(wc * 32 + fr, fq * 8);
#define PG8_SA(b, h) (((b) * 2 + (h)) * HTB)
#define PG8_SB(b, h) ((4 + (b) * 2 + (h)) * HTB)
#define PG8_STAGE(bufoff, gbase, voff) do { _Pragma("unroll") for (int _i = 0; _i < 2; ++_i) { unsigned _keep; \
        asm volatile("s_mov_b32 %0, m0\n\ts_mov_b32 m0, %3\n\ts_nop 0\n\tglobal_load_lds_dwordx4 %1, %2\n\ts_mov_b32 m0, %0" : "=&s"(_keep) : "v"((voff)[_i]), "s"((const char*)(gbase)), "s"(ldsb + (unsigned)(bufoff) + ldsw + (unsigned)(_i * 8192)) : "memory"); } } while (0)
#define PG8_LDA(dst, b, h) do { _Pragma("unroll") for (int m = 0; m < 4; ++m) _Pragma("unroll") for (int k = 0; k < 2; ++k) dst[m][k] = *(const PG8_LAS bf16x8*)(lds + PG8_SA(b, h) + aoff + m * 2048 + k * 1024); } while (0)
#define PG8_LDB(dst, b, h) do { _Pragma("unroll") for (int n = 0; n < 2; ++n) _Pragma("unroll") for (int k = 0; k < 2; ++k) dst[n][k] = *(const PG8_LAS bf16x8*)(lds + PG8_SB(b, h) + boff + n * 2048 + k * 1024); } while (0)
#define PG8_MMA(ai, bj, At, Bt) do { __builtin_amdgcn_s_setprio(1); _Pragma("unroll") for (int m = 0; m < 4; ++m) _Pragma("unroll") for (int n = 0; n < 2; ++n) { \
        if constexpr (FP8 == 2) { _Pragma("unroll") for (int k = 0; k < 2; ++k) acc[ai][bj][m][n] = __builtin_bit_cast(f32x4, __builtin_amdgcn_mfma_i32_16x16x64_i8(__builtin_bit_cast(i32x4, Bt[n][k]), __builtin_bit_cast(i32x4, At[m][k]), __builtin_bit_cast(i32x4, acc[ai][bj][m][n]), 0, 0, 0)); } \
        else if constexpr (FP8 == 1) { const i32x8 b8 = __builtin_shufflevector(__builtin_bit_cast(i32x4, Bt[n][0]), __builtin_bit_cast(i32x4, Bt[n][1]), 0, 1, 2, 3, 4, 5, 6, 7), a8 = __builtin_shufflevector(__builtin_bit_cast(i32x4, At[m][0]), __builtin_bit_cast(i32x4, At[m][1]), 0, 1, 2, 3, 4, 5, 6, 7); \
            acc[ai][bj][m][n] = __builtin_amdgcn_mfma_scale_f32_16x16x128_f8f6f4(b8, a8, acc[ai][bj][m][n], 0, 0, 0, 0x7F7F7F7F, 0, 0x7F7F7F7F); } \
        else { _Pragma("unroll") for (int k = 0; k < 2; ++k) acc[ai][bj][m][n] = __builtin_amdgcn_mfma_f32_16x16x32_bf16(Bt[n][k], At[m][k], acc[ai][bj][m][n], 0, 0, 0); } } \
        __builtin_amdgcn_s_setprio(0); } while (0)
#define PG8_WAIT_V(n) asm volatile("s_waitcnt vmcnt(" #n ")" ::: "memory")
#define PG8_WAIT_L(n) asm volatile("s_waitcnt lgkmcnt(" #n ")" ::: "memory")
#define PG8_BAR __builtin_amdgcn_s_barrier()
#define PG8_SCHED __builtin_amdgcn_sched_barrier(0)
    Unit cur, nxt; int ui = 0;
    if (!S.next(0, cur)) return;
    typename PreOf<Epi>::type pf;
    f32x4 acc[2][2][4][2];
#pragma unroll
    for (int a = 0; a < 2; ++a)
#pragma unroll
        for (int b = 0; b < 2; ++b)
#pragma unroll
            for (int m = 0; m < 4; ++m)
#pragma unroll
                for (int n = 0; n < 2; ++n) asm volatile("" : "=v"(acc[a][b][m][n]));
    bf16x8 At[4][2], B0[2][2], B1[2][2];
    const char* cA = (const char*)gA + (GATH ? (size_t)0 : cur.aoff); const char* cB = (const char*)gBt + cur.boff;
    constexpr size_t hA = GATH ? (size_t)0 : hstepA;
    unsigned gi0[2] = {0u, 0u}, gi1[2] = {0u, 0u}, ni0[2] = {0u, 0u}, ni1[2] = {0u, 0u}, gRow4[2] = {0u, 0u}, gC2[2] = {0u, 0u};
#define PG8_LDIDX(dst, idx) asm volatile("global_load_dword %0, %1, %2" : "=v"(dst) : "v"((unsigned)(idx)), "s"(S_inv) : "memory")
    const int* S_inv = nullptr;
    if constexpr (GATH) { S_inv = S.inv;
#pragma unroll
        for (int i = 0; i < 2; ++i) { int R, C; stage_rc(tid * 16 + i * 8192, R, C); gRow4[i] = (unsigned)R * 4u; gC2[i] = (unsigned)C * 2u;
            PG8_LDIDX(gi0[i], (unsigned)cur.gbase * 4u + gRow4[i]); PG8_LDIDX(gi1[i], (unsigned)cur.gbase * 4u + 512u + gRow4[i]); }
        asm volatile("s_waitcnt vmcnt(0)" ::: "memory");
#pragma unroll
        for (int i = 0; i < 2; ++i) { asm volatile("" : "+v"(gi0[i]), "+v"(gi1[i])); }
    }
    unsigned va0[2], va1[2];
#pragma unroll
    for (int i = 0; i < 2; ++i) { va0[i] = GATH ? gi0[i] * (unsigned)(LDA * 2) + gC2[i] : voffA[i]; va1[i] = GATH ? gi1[i] * (unsigned)(LDA * 2) + gC2[i] : voffA[i]; }
    PG8_STAGE(PG8_SB(0, 0), cB, voffB); PG8_STAGE(PG8_SB(0, 1), cB + hstepB, voffB); PG8_STAGE(PG8_SA(0, 0), cA, va0); PG8_STAGE(PG8_SA(0, 1), cA + hA, va1);
    if (wr == 1) PG8_BAR;
    PG8_WAIT_V(2); PG8_BAR;
    PG8_STAGE(PG8_SB(1, 0), cB + kstep, voffB); PG8_STAGE(PG8_SA(1, 0), cA + kstep, va0); PG8_STAGE(PG8_SB(1, 1), cB + hstepB + kstep, voffB);
    PG8_WAIT_V(6); PG8_BAR;
    for (;;) {
        const bool has_next = S.next(ui + 1, nxt);
        const char* nA = (has_next && !GATH) ? (const char*)gA + nxt.aoff : cA; const char* nB = has_next ? (const char*)gBt + nxt.boff : cB;
        if constexpr (GATH) { if (has_next) {
#pragma unroll
            for (int i = 0; i < 2; ++i) { PG8_LDIDX(ni0[i], (unsigned)nxt.gbase * 4u + gRow4[i]); PG8_LDIDX(ni1[i], (unsigned)nxt.gbase * 4u + 512u + gRow4[i]); } } }
        const int ntu = VARK ? cur.nkt : nt;
#pragma nounroll
        for (int t = 0; t < ntu; t += 2) {
            const bool last = (t == ntu - 2);
            const char* a1 = cA + (size_t)(t + 1) * kstep;
            const char* a2 = last ? nA : cA + (size_t)(t + 2) * kstep; const char* b2 = last ? nB : cB + (size_t)(t + 2) * kstep;
            const char* a3 = a2 + kstep; const char* b3 = b2 + kstep;
            unsigned sel0[2], sel1[2];
#pragma unroll
            for (int i = 0; i < 2; ++i) {
                if constexpr (GATH) { unsigned x0 = ni0[i], x1 = ni1[i]; asm volatile("" : "+v"(x0), "+v"(x1));
                    sel0[i] = last ? x0 * (unsigned)(LDA * 2) + gC2[i] : va0[i]; sel1[i] = last ? x1 * (unsigned)(LDA * 2) + gC2[i] : va1[i]; }
                else { sel0[i] = voffA[i]; sel1[i] = voffA[i]; } }
            PG8_LDB(B0, 0, 0); PG8_LDB(B1, 0, 1); PG8_SCHED; PG8_LDA(At, 0, 0); PG8_STAGE(PG8_SA(1, 1), a1 + hA, va1);
            if (t == 0) {
#pragma unroll
                for (int a = 0; a < 2; ++a)
#pragma unroll
                    for (int b = 0; b < 2; ++b)
#pragma unroll
                        for (int m = 0; m < 4; ++m)
#pragma unroll
                            for (int n = 0; n < 2; ++n) acc[a][b][m][n] = (f32x4){0.f, 0.f, 0.f, 0.f};
            }
            PG8_SCHED;
            PG8_WAIT_V(8); PG8_WAIT_L(0); PG8_BAR; PG8_MMA(0, 0, At, B0); PG8_MMA(0, 1, At, B1); PG8_BAR; PG8_SCHED;
            PG8_LDA(At, 0, 1); PG8_STAGE(PG8_SB(0, 0), b2, voffB); PG8_STAGE(PG8_SB(0, 1), b2 + hstepB, voffB); PG8_STAGE(PG8_SA(0, 0), a2, sel0);
            PG8_WAIT_V(8); PG8_WAIT_L(0); PG8_BAR; PG8_MMA(1, 0, At, B0); PG8_MMA(1, 1, At, B1); PG8_BAR; PG8_SCHED;
            PG8_LDB(B0, 1, 0); PG8_LDB(B1, 1, 1); PG8_SCHED; PG8_LDA(At, 1, 0); PG8_STAGE(PG8_SA(0, 1), a2 + hA, sel1);
            PG8_WAIT_V(8); PG8_WAIT_L(0); PG8_BAR; PG8_MMA(0, 0, At, B0); PG8_MMA(0, 1, At, B1); PG8_BAR; PG8_SCHED;
            PG8_LDA(At, 1, 1); PG8_STAGE(PG8_SB(1, 0), b3, voffB); PG8_STAGE(PG8_SB(1, 1), b3 + hstepB, voffB); PG8_STAGE(PG8_SA(1, 0), a3, sel0);
            PG8_WAIT_V(8); PG8_WAIT_L(0); PG8_BAR; PG8_MMA(1, 0, At, B0); PG8_MMA(1, 1, At, B1); PG8_BAR; PG8_SCHED;
        }
        if constexpr (ALIGN_EPI) { if (wr == 0) PG8_BAR; }
        typename Hook::Regs hkr;
        if constexpr (Epi::PRE) { E.pre(cur, wr, wc, pf); asm volatile("" ::: "memory"); }
        if constexpr (Hook::ON) HK.issue(ui * S.G + S.c, wid, hkr);
        if constexpr (Epi::PRE) E(acc, cur, wr, wc, pf); else E(acc, cur, wr, wc);
        if constexpr (Hook::ON) HK.finish(wid, hkr);
        if (!has_next) break;
#pragma unroll
        for (int a = 0; a < 2; ++a)
#pragma unroll
            for (int b = 0; b < 2; ++b)
#pragma unroll
                for (int m = 0; m < 4; ++m)
#pragma unroll
                    for (int n = 0; n < 2; ++n) asm volatile("" : "=v"(acc[a][b][m][n]));
        cur = nxt; cA = nA; cB = nB; ++ui;
        if constexpr (GATH) {
#pragma unroll
            for (int i = 0; i < 2; ++i) { gi0[i] = ni0[i]; gi1[i] = ni1[i]; va0[i] = gi0[i] * (unsigned)(LDA * 2) + gC2[i]; va1[i] = gi1[i] * (unsigned)(LDA * 2) + gC2[i]; } }
        if constexpr (ALIGN_EPI) { if (wr == 1) PG8_BAR; }
    }
    PG8_WAIT_V(0);
    if constexpr (!ALIGN_EPI) { if (wr == 0) PG8_BAR; }
    PG8_BAR;
#undef PG8_SA
#undef PG8_SB
#undef PG8_STAGE
#undef PG8_LDIDX
#undef PG8_LDA
#undef PG8_LDB
#undef PG8_MMA
#undef PG8_WAIT_V
#undef PG8_WAIT_L
#undef PG8_BAR
#undef PG8_SCHED
}
}

constexpr int NWAVES = 8;
constexpr int SEQ = 4096, M = 8192, D = 2048, DFF = 5632, NE = 8, INC = 8192, PW = 1024;
constexpr float RMS_EPS = 1e-6f;
constexpr int MOE_MAX_TILES = 72;
constexpr int MOE_DOWN_KSPLIT = 1;
constexpr size_t MiB = 1u << 20;
constexpr size_t WS_CTL = 0, CTL_ZERO_BYTES = 1 * MiB;
constexpr size_t WS_TOK = 1 * MiB;
constexpr size_t WS_WIN = 2 * MiB;
constexpr size_t WS_POOLW = 66 * MiB;
constexpr size_t WS_WPU = 67 * MiB;
constexpr size_t WS_WAU = 75 * MiB;
constexpr size_t WS_WOUT = 83 * MiB;
constexpr size_t WS_FGU = 99 * MiB;
constexpr size_t WS_FD = 143 * MiB;
constexpr size_t WS_MGU = 165 * MiB;
constexpr size_t WS_MD = 517 * MiB;
constexpr size_t WS_X = 693 * MiB;
constexpr size_t WS_H = 757 * MiB;
constexpr size_t WS_MIX = 789 * MiB;
constexpr size_t WS_UPOOL = WS_MIX, WS_Q = WS_MIX + 16 * MiB, WS_K = WS_MIX + 32 * MiB, WS_VT = WS_MIX + 48 * MiB, WS_GATES = WS_MIX + 64 * MiB,
                 WS_POOLED = WS_MIX + 128 * MiB, WS_YPOOL = WS_MIX + 144 * MiB, WS_YATTN = WS_MIX + 160 * MiB, WS_T = WS_MIX + 176 * MiB, WS_MERGED = WS_MIX + 208 * MiB;
constexpr size_t WS_G = WS_MIX;
constexpr size_t WS_HS = 1029 * MiB;
constexpr size_t WS_Y = 1101 * MiB;
constexpr size_t WS_Y2 = 1173 * MiB;
constexpr size_t WS_END = 1245 * MiB;
static_assert((size_t)MOE_MAX_TILES * 256 * DFF * 2 <= 240 * MiB, "G overlay");
constexpr int CW_BAR = 4096;
constexpr int CW_ECNT = 8192;
constexpr int CW_COLMAX = 32768;
constexpr int CW_COLMAX_WIN = 49152;
constexpr int CW_INV = 131072;
constexpr int CW_KPART = 16384;
constexpr int RING_OFF = 0, RING_BYTES = 131072;
constexpr int LDSCTL_OFF = RING_BYTES, MISC_OFF = LDSCTL_OFF + 320;
constexpr int LDS_BYTES = 147456;

#define GAS __attribute__((address_space(1)))
#define LAS __attribute__((address_space(3)))
typedef unsigned short bf16;
typedef unsigned v4u __attribute__((ext_vector_type(4)));
typedef unsigned v2u __attribute__((ext_vector_type(2)));
typedef float f32x4 __attribute__((ext_vector_type(4)));
typedef float f32x2 __attribute__((ext_vector_type(2)));
typedef float f32x16 __attribute__((ext_vector_type(16)));
typedef unsigned u32x2_t __attribute__((ext_vector_type(2)));
typedef short bf16x8 __attribute__((ext_vector_type(8)));
typedef short s16x4 __attribute__((ext_vector_type(4)));
typedef __bf16 bf2_t __attribute__((ext_vector_type(2)));
typedef GAS unsigned gu32;
#define RLX_AGENT __ATOMIC_RELAXED, __HIP_MEMORY_SCOPE_AGENT
__device__ __forceinline__ unsigned pk2(float lo, float hi) { f32x2 v = {lo, hi}; return __builtin_bit_cast(unsigned, __builtin_convertvector(v, bf2_t)); }
__device__ __forceinline__ float bflo(unsigned w) { return __uint_as_float(w << 16); }
__device__ __forceinline__ float bfhi(unsigned w) { return __uint_as_float(w & 0xffff0000u); }
template <int K> __device__ __forceinline__ float xor_lt32(float v) { return __int_as_float(__builtin_amdgcn_ds_swizzle(__float_as_int(v), (K << 10) | 0x1F)); }
__device__ __forceinline__ float half_sum(float v) { const auto p = __builtin_amdgcn_permlane32_swap(__float_as_uint(v), __float_as_uint(v), false, false); return __uint_as_float(p[0]) + __uint_as_float(p[1]); }
__device__ __forceinline__ float other_half(float v, int hh) { const auto p = __builtin_amdgcn_permlane32_swap(__float_as_uint(v), __float_as_uint(v), false, false); return __uint_as_float(hh ? p[0] : p[1]); }
__device__ __forceinline__ float wave_sum(float v) {
    v += xor_lt32<1>(v); v += xor_lt32<2>(v); v += xor_lt32<4>(v); v += xor_lt32<8>(v); v += xor_lt32<16>(v);
    return half_sum(v);
}

#define XB_TMO      128
#define XB_XCNT(j)  (256  + 64 * (j))
#define XB_XSUB(j)  (1280 + 64 * (j))
#define XB_XGEN(j)  (2304 + 64 * (j))
#define XB_TOP      3328
#define XB_TOPGEN   3392
#define XCD_BAR_WORDS 3456
#define XB_SPIN_CAP (1u << 18)
__device__ __forceinline__ unsigned xb_ld(unsigned* p)              { return __hip_atomic_load(p, __ATOMIC_RELAXED, __HIP_MEMORY_SCOPE_AGENT); }
__device__ __forceinline__ unsigned xb_add(unsigned* p, unsigned v) { return __hip_atomic_fetch_add(p, v, __ATOMIC_RELAXED, __HIP_MEMORY_SCOPE_AGENT); }
__device__ __forceinline__ unsigned xb_xcc_id() { return (unsigned)__builtin_amdgcn_s_getreg((3 << 11) | 20) & 0xFu; }
#define XB_SPIN(cond, bar) do { unsigned _sp = 0; while (cond) { __builtin_amdgcn_s_sleep(1); \
    if ((++_sp & 255u) == 0u) { if (xb_ld(&(bar)[XB_TMO])) break; if (_sp > XB_SPIN_CAP) { atomicAdd(&(bar)[XB_TMO], 1u); break; } } } } while (0)
struct XcdBarrier { unsigned* bar; unsigned x; volatile LAS unsigned* st; };
__device__ __forceinline__ XcdBarrier xcd_barrier_post(unsigned* bar, volatile LAS unsigned* st) {
    XcdBarrier b; b.bar = bar; b.x = xb_xcc_id(); b.st = st;
    if (threadIdx.x == 0) (void)xb_add(&bar[XB_XCNT(b.x)], 1u);
    return b;
}
__device__ __forceinline__ void xcd_barrier_complete(unsigned* bar, unsigned x, unsigned& nloc, unsigned& nx) {
    const unsigned G = gridDim.x * gridDim.y * gridDim.z;
    unsigned sum, cnt, mine, sp = 0u;
    for (;;) {
        sum = 0u; cnt = 0u; mine = 0u;
#pragma unroll
        for (unsigned j = 0; j < 16; ++j) { const unsigned c = xb_ld(&bar[XB_XCNT(j)]); sum += c; cnt += (c > 0u) ? 1u : 0u; mine = (j == x) ? c : mine; }
        if (sum == G) break;
        __builtin_amdgcn_s_sleep(1);
        if ((++sp & 255u) == 0u) { if (xb_ld(&bar[XB_TMO])) break; if (sp > XB_SPIN_CAP) { atomicAdd(&bar[XB_TMO], 1u); break; } }
    }
    nloc = mine > 0u ? mine : 1u; nx = cnt > 0u ? cnt : 1u;
}
__device__ __forceinline__ void xcd_barrier(const XcdBarrier& b) {
    asm volatile("s_waitcnt vmcnt(0)" ::: "memory");
    __syncthreads();
    if (threadIdx.x == 0) {
        unsigned* bar = b.bar; asm volatile("" : "+s"(bar));
        __builtin_amdgcn_s_waitcnt(0);
        unsigned nloc = b.st[0], nx = b.st[1];
        if (nloc == 0u) { xcd_barrier_complete(bar, b.x, nloc, nx); b.st[0] = nloc; b.st[1] = nx; }
        const unsigned old = xb_add(&bar[XB_XSUB(b.x)], 1u);
        const unsigned gen = old / nloc;
        if (old + 1u == (gen + 1u) * nloc) {
            __builtin_amdgcn_fence(__ATOMIC_RELEASE, "agent");
            asm volatile("s_waitcnt vmcnt(0)" ::: "memory");
            const unsigned og = xb_add(&bar[XB_TOP], 1u);
            const unsigned tg = og / nx;
            if (og + 1u == (tg + 1u) * nx) xb_add(&bar[XB_TOPGEN], 1u);
            else XB_SPIN(xb_ld(&bar[XB_TOPGEN]) == tg, bar);
            __builtin_amdgcn_fence(__ATOMIC_ACQUIRE, "agent");
            xb_add(&bar[XB_XGEN(b.x)], 1u);
            asm volatile("s_waitcnt vmcnt(0)" ::: "memory");
        } else {
            XB_SPIN(xb_ld(&bar[XB_XGEN(b.x)]) == gen, bar);
            __builtin_amdgcn_fence(__ATOMIC_ACQUIRE, "agent");
            asm volatile("s_waitcnt vmcnt(0)" ::: "memory");
        }
    }
    __syncthreads();
}

struct Args { const float* in[17]; float* out; unsigned char* ws; int ph_lo, ph_hi; };
typedef const __attribute__((address_space(4))) Args* ArgsP;
__device__ __forceinline__ ArgsP argp() {
#if defined(__HIP_DEVICE_COMPILE__)
    ArgsP p = (ArgsP)__builtin_amdgcn_kernarg_segment_ptr(); asm volatile("" : "+s"(p)); return p;
#else
    return nullptr;
#endif
}

__device__ __forceinline__ void cvt_load(const float* W, int N, int k0, int n0, int lane, f32x4 (&v)[8]) {
    const float* p = W + (size_t)(k0 + 8 * (lane >> 3)) * N + n0 + 4 * (lane & 7);
#pragma unroll
    for (int it = 0; it < 8; ++it) v[it] = __builtin_nontemporal_load((const f32x4*)(p + (size_t)it * N));
}
__device__ __forceinline__ void cvt_store(bf16* WT, int ldk, int k0, int n0, int rowmode, int lane, const f32x4 (&v)[8]) {
#pragma unroll
    for (int j = 0; j < 4; ++j) { const int n = n0 + 4 * (lane & 7) + j; const int nr = rowmode == 0 ? n : (256 * (n >> 7) + (n & 127) + (rowmode == 2 ? 128 : 0));
        v4u a; a.x = pk2(v[0][j], v[1][j]); a.y = pk2(v[2][j], v[3][j]); a.z = pk2(v[4][j], v[5][j]); a.w = pk2(v[6][j], v[7][j]);
        __builtin_nontemporal_store(a, (v4u*)(WT + (size_t)nr * ldk + k0 + 8 * (lane >> 3))); }
}
struct CvtTile { const float* W; bf16* WT; int N, ldk, k0, n0, mode; const unsigned* cm; };
constexpr int PP_WIN = 32 * 256, PP_FF = 32 * 176;
constexpr int T_WIN = 16 * 256, T_FF8 = 16 * 176;
constexpr int T_PW = 32, T_UP = 16 * 64, T_OUT = 32 * 64, T_FF = 88 * 64;
static_assert((DFF / 128) * (D / 32) == T_FF8, "tile counts");
constexpr int T_LAYER = T_WIN + 4 * T_PW + 2 * T_UP + T_OUT;
constexpr int SEG_A0 = 0, SEG_B0 = T_LAYER, SEG_C0 = SEG_B0 + 2 * T_FF8 + T_FF, SEG_D0 = SEG_C0 + T_LAYER, SEG_E0 = SEG_D0 + 16 * T_FF8, CVT_TILES = SEG_E0 + 8 * T_FF8;
__device__ __forceinline__ void cvt_lookup(ArgsP a, int t, CvtTile& c) {
    unsigned char* ws = a->ws;
    int in = 0; size_t soff = 0, doff = 0; int K = 0, N = 0, mode = 0, cmo = 0;
    if (t < SEG_B0 || (t >= SEG_C0 && t < SEG_D0)) { const int l = t < SEG_B0 ? 0 : 1; int r = t - (l ? SEG_C0 : 0);
        if (r < T_WIN) { in = 2; soff = (size_t)l * D * INC; doff = WS_WIN + (size_t)l * INC * D * 2; K = D; N = INC; t = r; mode = 8; cmo = CW_COLMAX_WIN + l * INC; }
        else if ((r -= T_WIN) < 4 * T_PW) { const int g = r / T_PW; in = 3; soff = (size_t)(l * 4 + g) * 65536; doff = WS_POOLW + (size_t)(l * 4 + g) * 65536 * 2; K = 256; N = 256; t = r % T_PW; }
        else if ((r -= 4 * T_PW) < T_UP) { in = 5; soff = (size_t)l * PW * D; doff = WS_WPU + (size_t)l * D * PW * 2; K = PW; N = D; t = r; }
        else if ((r -= T_UP) < T_UP) { in = 6; soff = (size_t)l * PW * D; doff = WS_WAU + (size_t)l * D * PW * 2; K = PW; N = D; t = r; }
        else { r -= T_UP; in = 7; soff = (size_t)l * D * D; doff = WS_WOUT + (size_t)l * D * D * 2; K = D; N = D; t = r; }
    } else if (t < SEG_C0) { t -= SEG_B0;
        if (t < 2 * T_FF8) { const int w = t / T_FF8; t %= T_FF8; in = 9 + w; doff = WS_FGU; K = D; N = DFF; mode = (1 + w) | 8; cmo = CW_COLMAX + w * DFF; }
        else { t -= 2 * T_FF8; in = 11; doff = WS_FD; K = DFF; N = D; if (DENSE_DOWN_FP8) mode = 4; }
    } else if (t < SEG_E0) { t -= SEG_D0; const int e = t / (2 * T_FF8); t %= 2 * T_FF8; const int w = t / T_FF8; t %= T_FF8; in = 13 + w; soff = (size_t)e * D * DFF;
        doff = WS_MGU + (size_t)e * 2 * DFF * D; K = D; N = DFF; mode = (1 + w) | 4;
    } else { t -= SEG_E0; const int e = t / T_FF8; t %= T_FF8; in = 15; soff = (size_t)e * D * DFF; doff = WS_MD + (size_t)e * D * DFF; K = DFF; N = D; mode = 4; }
    const int ntn = N / 32;
    c.W = a->in[in] + soff; c.WT = (bf16*)(ws + doff); c.N = N; c.ldk = K; c.k0 = ((mode & 12) ? 128 : 64) * (t / ntn); c.n0 = 32 * (t % ntn); c.mode = mode; c.cm = (const unsigned*)(ws + WS_CTL) + cmo;
}
__device__ __forceinline__ void cvt_range(ArgsP A, int first, int last, int widx, int nw, int lane) {
    for (int t = first + widx; t < last; t += 4 * nw) {
        CvtTile c0, c1, c2, c3; const int t1 = t + nw, t2 = t + 2 * nw, t3 = t + 3 * nw;
        cvt_lookup(A, t, c0); cvt_lookup(A, t1 < last ? t1 : t, c1); cvt_lookup(A, t2 < last ? t2 : t, c2); cvt_lookup(A, t3 < last ? t3 : t, c3);
        f32x4 va[8], vb[8], vc[8], vd[8];
        cvt_load(c0.W, c0.N, c0.k0, c0.n0, lane, va); cvt_load(c1.W, c1.N, c1.k0, c1.n0, lane, vb); cvt_load(c2.W, c2.N, c2.k0, c2.n0, lane, vc); cvt_load(c3.W, c3.N, c3.k0, c3.n0, lane, vd);
        cvt_store(c0.WT, c0.ldk, c0.k0, c0.n0, c0.mode, lane, va);
        if (t1 < last) cvt_store(c1.WT, c1.ldk, c1.k0, c1.n0, c1.mode, lane, vb);
        if (t2 < last) cvt_store(c2.WT, c2.ldk, c2.k0, c2.n0, c2.mode, lane, vc);
        if (t3 < last) cvt_store(c3.WT, c3.ldk, c3.k0, c3.n0, c3.mode, lane, vd);
    }
}
__device__ __forceinline__ unsigned pk4_i8(float a, float b, float c, float d);
__device__ __forceinline__ void cvt_load_big(const float* W, int N, int k0, int n0, int lane, f32x4 (&v)[16]) {
    const float* p = W + (size_t)(k0 + 16 * (lane >> 3)) * N + n0 + 4 * (lane & 7);
#pragma unroll
    for (int it = 0; it < 16; ++it) v[it] = __builtin_nontemporal_load((const f32x4*)(p + (size_t)it * N));
}
__device__ __forceinline__ void cvt_store_big(const CvtTile& c, int lane, const f32x4 (&v)[16]) {
    const int rowmode = c.mode & 3; v4u cmx = {0u, 0u, 0u, 0u};
    if (c.mode & 8) cmx = *(const v4u*)(c.cm + c.n0 + 4 * (lane & 7));
#pragma unroll
    for (int j = 0; j < 4; ++j) { const int n = c.n0 + 4 * (lane & 7) + j; const int nr = rowmode == 0 ? n : (256 * (n >> 7) + (n & 127) + (rowmode == 2 ? 128 : 0));
        v4u a;
        if (c.mode & 8) { const float mx = __uint_as_float(cmx[j]), s = mx > 0.f ? 127.0f / mx : 0.f;
            a.x = pk4_i8(v[0][j] * s, v[1][j] * s, v[2][j] * s, v[3][j] * s); a.y = pk4_i8(v[4][j] * s, v[5][j] * s, v[6][j] * s, v[7][j] * s);
            a.z = pk4_i8(v[8][j] * s, v[9][j] * s, v[10][j] * s, v[11][j] * s); a.w = pk4_i8(v[12][j] * s, v[13][j] * s, v[14][j] * s, v[15][j] * s); }
        else { const float s = pg8::FP8_W_SCALE;
            a.x = pg8::pk4_fp8(v[0][j] * s, v[1][j] * s, v[2][j] * s, v[3][j] * s); a.y = pg8::pk4_fp8(v[4][j] * s, v[5][j] * s, v[6][j] * s, v[7][j] * s);
            a.z = pg8::pk4_fp8(v[8][j] * s, v[9][j] * s, v[10][j] * s, v[11][j] * s); a.w = pg8::pk4_fp8(v[12][j] * s, v[13][j] * s, v[14][j] * s, v[15][j] * s); }
        __builtin_nontemporal_store(a, (v4u*)((unsigned char*)c.WT + (size_t)nr * c.ldk + c.k0 + 16 * (lane >> 3))); }
}
__device__ __forceinline__ void cvt_range_big(ArgsP A, int first, int last, int widx, int nw, int lane) {
    for (int t = first + widx; t < last; t += 2 * nw) {
        CvtTile c0, c1; const int t1 = t + nw;
        cvt_lookup(A, t, c0); cvt_lookup(A, t1 < last ? t1 : t, c1);
        f32x4 va[16], vb[16];
        cvt_load_big(c0.W, c0.N, c0.k0, c0.n0, lane, va); cvt_load_big(c1.W, c1.N, c1.k0, c1.n0, lane, vb);
        cvt_store_big(c0, lane, va);
        if (t1 < last) cvt_store_big(c1, lane, vb);
    }
}
constexpr int PROJ_CVT = 2048;
constexpr int POOL_CVT = 4096;
template <bool EN> struct CvtHookT {
    static constexpr bool ON = EN;
    int first, last;
    struct Regs { f32x4 v[8]; int t; };
    __device__ __forceinline__ void issue(int L, int wid, Regs& r) const {
        const int t = first + L * HK_TPU + (wid >> 1); r.t = (t < last && (wid >> 1) < HK_TPU) ? t : -1;
        { CvtTile c; cvt_lookup(argp(), r.t >= 0 ? r.t : SEG_D0, c); const int lane = pg8::lane_id_now(); const int Ns = r.t >= 0 ? c.N : 0;
            const float* p = c.W + (size_t)(c.k0 + 16 * (lane >> 3) + 8 * (wid & 1)) * Ns + c.n0 + 4 * (lane & 7);
#pragma unroll
            for (int it = 0; it < 8; ++it) r.v[it] = __builtin_nontemporal_load((const f32x4*)(p + (size_t)it * Ns)); }
    }
    __device__ __forceinline__ void finish(int wid, Regs& r) const {
        if (r.t >= 0) { CvtTile c; cvt_lookup(argp(), r.t, c); const int lane = pg8::lane_id_now(); const int rowmode = c.mode & 3; const float s = pg8::FP8_W_SCALE;
#pragma unroll
            for (int j = 0; j < 4; ++j) { const int n = c.n0 + 4 * (lane & 7) + j; const int nr = rowmode == 0 ? n : (256 * (n >> 7) + (n & 127) + (rowmode == 2 ? 128 : 0));
                pg8::u32x2 a; a.x = pg8::pk4_fp8(r.v[0][j] * s, r.v[1][j] * s, r.v[2][j] * s, r.v[3][j] * s); a.y = pg8::pk4_fp8(r.v[4][j] * s, r.v[5][j] * s, r.v[6][j] * s, r.v[7][j] * s);
                *(pg8::u32x2*)((unsigned char*)c.WT + (size_t)nr * c.ldk + c.k0 + 16 * (lane >> 3) + 8 * (wid & 1)) = a; } }
    }
};
constexpr int CONV_TILES_PER_CU_ROUND_F8 = 32;
constexpr int FGU_G = 240;
constexpr int Q7 = (256 - FGU_G) * 6 * CONV_TILES_PER_CU_ROUND_F8;
constexpr int FGU_CVT = Q7 - (T_LAYER - T_WIN) / 2;
static_assert(FGU_CVT > 0, "conversion quota");
__device__ __forceinline__ float half_max(float v) { const auto p = __builtin_amdgcn_permlane32_swap(__float_as_uint(v), __float_as_uint(v), false, false); return fmaxf(__uint_as_float(p[0]), __uint_as_float(p[1])); }
__device__ __forceinline__ float wave_max(float v) {
    v = fmaxf(v, xor_lt32<1>(v)); v = fmaxf(v, xor_lt32<2>(v)); v = fmaxf(v, xor_lt32<4>(v)); v = fmaxf(v, xor_lt32<8>(v)); v = fmaxf(v, xor_lt32<16>(v));
    return half_max(v);
}
__device__ __forceinline__ void colmax_tile(const float* W, int N, int k0, int n0, int lane, unsigned* cm) {
    f32x4 v[8]; cvt_load(W, N, k0, n0, lane, v);
    f32x4 m = {0.f, 0.f, 0.f, 0.f};
#pragma unroll
    for (int it = 0; it < 8; ++it)
#pragma unroll
        for (int j = 0; j < 4; ++j) m[j] = fmaxf(m[j], fabsf(v[it][j]));
#pragma unroll
    for (int j = 0; j < 4; ++j) { float x = m[j]; x = fmaxf(x, xor_lt32<8>(x)); x = fmaxf(x, xor_lt32<16>(x)); x = half_max(x); m[j] = x; }
    if (lane < 8) {
#pragma unroll
        for (int j = 0; j < 4; ++j) __hip_atomic_fetch_max(cm + n0 + 4 * lane + j, __float_as_uint(m[j]), __ATOMIC_RELAXED, __HIP_MEMORY_SCOPE_AGENT); }
}
__device__ __forceinline__ unsigned pk4_i8(float a, float b, float c, float d) {
    float hi = 127.f; asm volatile("" : "+s"(hi));
    const int ia = (int)__builtin_rintf(__builtin_amdgcn_fmed3f(a, -hi, hi)), ib = (int)__builtin_rintf(__builtin_amdgcn_fmed3f(b, -hi, hi));
    const int ic = (int)__builtin_rintf(__builtin_amdgcn_fmed3f(c, -hi, hi)), id = (int)__builtin_rintf(__builtin_amdgcn_fmed3f(d, -hi, hi));
    return (unsigned)(ia & 0xff) | ((unsigned)(ib & 0xff) << 8) | ((unsigned)(ic & 0xff) << 16) | ((unsigned)(id & 0xff) << 24);
}
constexpr int STRIPS_WIN = INC / 32, STRIPS_FF = DFF / 32, N_STRIPS = 2 * STRIPS_WIN + 2 * STRIPS_FF;
struct StripDesc { const float* W; unsigned char* WT; unsigned* cm; int N, rowmode, n0; };
__device__ __forceinline__ StripDesc strip_lookup(ArgsP A, int sidx) {
    int in, N, rowmode, cmo, n0; size_t soff, doff;
    if (sidx < STRIPS_WIN) { in = 2; N = INC; rowmode = 0; cmo = CW_COLMAX_WIN; soff = 0; doff = WS_WIN; n0 = 32 * sidx; }
    else if (sidx < STRIPS_WIN + STRIPS_FF) { in = 9; N = DFF; rowmode = 1; cmo = CW_COLMAX; soff = 0; doff = WS_FGU; n0 = 32 * (sidx - STRIPS_WIN); }
    else if (sidx < STRIPS_WIN + 2 * STRIPS_FF) { in = 10; N = DFF; rowmode = 2; cmo = CW_COLMAX + DFF; soff = 0; doff = WS_FGU; n0 = 32 * (sidx - STRIPS_WIN - STRIPS_FF); }
    else { in = 2; N = INC; rowmode = 0; cmo = CW_COLMAX_WIN + INC; soff = (size_t)D * INC; doff = WS_WIN + (size_t)INC * D * 2; n0 = 32 * (sidx - STRIPS_WIN - 2 * STRIPS_FF); }
    StripDesc d; d.W = A->in[in] + soff; d.WT = A->ws + doff; d.cm = (unsigned*)(A->ws + WS_CTL) + cmo; d.N = N; d.rowmode = rowmode; d.n0 = n0; return d;
}
__device__ __forceinline__ void strip_load(const StripDesc& d, int wave, int lane, int half, f32x4 (&v)[16]) {
    const float* p = d.W + (size_t)(256 * wave + 128 * half + (lane >> 3)) * d.N + d.n0 + 4 * (lane & 7);
#pragma unroll
    for (int it = 0; it < 16; ++it) v[it] = __builtin_nontemporal_load((const f32x4*)(p + (size_t)(8 * it) * d.N));
}
__device__ __forceinline__ void strip_park(LAS unsigned char* lds, int wave, int lane, int half, const f32x4 (&v)[16], float (&mx)[4]) {
    const int c = lane & 7, r8 = lane >> 3;
#pragma unroll
    for (int it = 0; it < 16; ++it) { const int k = 256 * wave + 128 * half + 8 * it + r8;
        mx[0] = fmaxf(mx[0], fabsf(v[it].x)); mx[1] = fmaxf(mx[1], fabsf(v[it].y)); mx[2] = fmaxf(mx[2], fabsf(v[it].z)); mx[3] = fmaxf(mx[3], fabsf(v[it].w));
        *(LAS u32x2_t*)(lds + k * 64 + ((c ^ ((k >> 4) & 7)) * 8)) = (u32x2_t){pk2(v[it].x, v[it].y), pk2(v[it].z, v[it].w)}; }
}
__device__ __forceinline__ void strips_to_i8(ArgsP A, LAS unsigned char* lds, int first, int stride, int wave, int lane) {
    const int c = lane & 7, r8 = lane >> 3;
    f32x4 v[16];
    if (first < N_STRIPS) { const StripDesc d0 = strip_lookup(A, first); strip_load(d0, wave, lane, 0, v); }
    for (int sidx = first; sidx < N_STRIPS; sidx += stride) {
        const StripDesc d = strip_lookup(A, sidx);
        float mx[4] = {0.f, 0.f, 0.f, 0.f};
        strip_park(lds, wave, lane, 0, v, mx);
        strip_load(d, wave, lane, 1, v);
        strip_park(lds, wave, lane, 1, v, mx);
        LAS float* red = (LAS float*)(lds + LDSCTL_OFF + 2048);
#pragma unroll
        for (int j = 0; j < 4; ++j) { float x = mx[j]; x = fmaxf(x, xor_lt32<8>(x)); x = fmaxf(x, xor_lt32<16>(x)); x = half_max(x); mx[j] = x; }
        if (lane < 8) *(LAS f32x4*)(red + wave * 32 + 4 * lane) = (f32x4){mx[0], mx[1], mx[2], mx[3]};
        __syncthreads();
        if (sidx + stride < N_STRIPS) { const StripDesc dn = strip_lookup(A, sidx + stride); strip_load(dn, wave, lane, 0, v); }
        f32x4 m = *(const LAS f32x4*)(red + 4 * c);
#pragma unroll
        for (int w = 1; w < 8; ++w) { const f32x4 t = *(const LAS f32x4*)(red + w * 32 + 4 * c); m.x = fmaxf(m.x, t.x); m.y = fmaxf(m.y, t.y); m.z = fmaxf(m.z, t.z); m.w = fmaxf(m.w, t.w); }
        if (wave == 0 && lane < 8) *(v4u*)(d.cm + d.n0 + 4 * lane) = (v4u){__float_as_uint(m.x), __float_as_uint(m.y), __float_as_uint(m.z), __float_as_uint(m.w)};
        float sc[4]; sc[0] = m.x > 0.f ? 127.0f / m.x : 0.f; sc[1] = m.y > 0.f ? 127.0f / m.y : 0.f; sc[2] = m.z > 0.f ? 127.0f / m.z : 0.f; sc[3] = m.w > 0.f ? 127.0f / m.w : 0.f;
#pragma unroll
        for (int u = 0; u < 2; ++u) { const int kt = 2 * wave + u, q = r8;
            float wv[16][4];
#pragma unroll
            for (int it = 0; it < 16; ++it) { const int k = 128 * kt + 16 * q + it; const u32x2_t x = *(const LAS u32x2_t*)(lds + k * 64 + ((c ^ q) * 8));
                wv[it][0] = bflo(x.x); wv[it][1] = bfhi(x.x); wv[it][2] = bflo(x.y); wv[it][3] = bfhi(x.y); }
#pragma unroll
            for (int j = 0; j < 4; ++j) { const int n = d.n0 + 4 * c + j; const int nr = d.rowmode == 0 ? n : (256 * (n >> 7) + (n & 127) + (d.rowmode == 2 ? 128 : 0)); const float sj = sc[j];
                v4u a; a.x = pk4_i8(wv[0][j] * sj, wv[1][j] * sj, wv[2][j] * sj, wv[3][j] * sj); a.y = pk4_i8(wv[4][j] * sj, wv[5][j] * sj, wv[6][j] * sj, wv[7][j] * sj);
                a.z = pk4_i8(wv[8][j] * sj, wv[9][j] * sj, wv[10][j] * sj, wv[11][j] * sj); a.w = pk4_i8(wv[12][j] * sj, wv[13][j] * sj, wv[14][j] * sj, wv[15][j] * sj);
                __builtin_nontemporal_store(a, (v4u*)(d.WT + (size_t)nr * D + 128 * kt + 16 * q)); } }
        __syncthreads();
    }
}
template <int R> __device__ __forceinline__ void rms_rows_to_i8(const float* X, const float* gain, unsigned char* H8, float* rowscale, int m0, int stride, int lane) {
    f32x4 v[R][8];
#pragma unroll
    for (int r = 0; r < R; ++r) { const int m = (m0 + r * stride) < M ? (m0 + r * stride) : m0; const f32x4* xr = (const f32x4*)(X + (size_t)m * D) + lane;
#pragma unroll
        for (int j = 0; j < 8; ++j) v[r][j] = xr[64 * j]; }
    const f32x4* gr = (const f32x4*)gain + lane;
#pragma unroll
    for (int r = 0; r < R; ++r) { float t = 0.f;
#pragma unroll
        for (int j = 0; j < 8; ++j) t += (v[r][j].x * v[r][j].x + v[r][j].y * v[r][j].y) + (v[r][j].z * v[r][j].z + v[r][j].w * v[r][j].w);
        const float rstd = 1.0f / sqrtf(wave_sum(t) * (1.f / D) + RMS_EPS); float mx = 0.f;
#pragma unroll
        for (int j = 0; j < 8; ++j) { const f32x4 g = gr[64 * j]; v[r][j].x *= rstd * g.x; v[r][j].y *= rstd * g.y; v[r][j].z *= rstd * g.z; v[r][j].w *= rstd * g.w;
            mx = fmaxf(mx, fmaxf(fmaxf(fabsf(v[r][j].x), fabsf(v[r][j].y)), fmaxf(fabsf(v[r][j].z), fabsf(v[r][j].w)))); }
        mx = wave_max(mx); const float s = mx > 0.f ? 127.0f / mx : 0.f;
        if ((m0 + r * stride) < M) { const int m = m0 + r * stride; if (lane == 0) rowscale[m] = mx * (1.0f / 127.0f);
#pragma unroll
            for (int j = 0; j < 8; ++j) ((unsigned*)(H8 + (size_t)m * D) + lane)[64 * j] = pk4_i8(v[r][j].x * s, v[r][j].y * s, v[r][j].z * s, v[r][j].w * s); } }
}

template <int R> __device__ __forceinline__ void rms_rows_to_bf16(const float* X, const float* gain, bf16* H, int m0, int stride, int lane) {
    f32x4 v[R][8]; float s[R];
#pragma unroll
    for (int r = 0; r < R; ++r) { const int m = (m0 + r * stride) < M ? (m0 + r * stride) : m0; const f32x4* xr = (const f32x4*)(X + (size_t)m * D) + lane;
#pragma unroll
        for (int j = 0; j < 8; ++j) v[r][j] = xr[64 * j]; }
#pragma unroll
    for (int r = 0; r < R; ++r) { float t = 0.f;
#pragma unroll
        for (int j = 0; j < 8; ++j) t += (v[r][j].x * v[r][j].x + v[r][j].y * v[r][j].y) + (v[r][j].z * v[r][j].z + v[r][j].w * v[r][j].w);
        s[r] = 1.0f / sqrtf(wave_sum(t) * (1.f / D) + RMS_EPS); }
    const f32x4* gr = (const f32x4*)gain + lane;
#pragma unroll
    for (int j = 0; j < 8; ++j) { const f32x4 g = gr[64 * j];
#pragma unroll
        for (int r = 0; r < R; ++r) if ((m0 + r * stride) < M) { v2u w; w.x = pk2(v[r][j].x * s[r] * g.x, v[r][j].y * s[r] * g.y); w.y = pk2(v[r][j].z * s[r] * g.z, v[r][j].w * s[r] * g.w);
            ((v2u*)(H + (size_t)(m0 + r * stride) * D) + lane)[64 * j] = w; } }
}

__device__ __forceinline__ void attn_item(const bf16* Q, const bf16* K2, const bf16* V3, bf16* Y, int b, int h, int qb, int lane) {
    const int r = lane & 31, hh = lane >> 5, q0 = qb * 32;
    const size_t tok0 = (size_t)b * SEQ;
    const int bh = b * 8 + h;
    bf16x8 qf[8];
    { const bf16* qrow = Q + (tok0 + q0 + r) * 1024 + h * 128 + 8 * hh;
#pragma unroll
      for (int s = 0; s < 8; ++s) qf[s] = *(const bf16x8*)(qrow + 16 * s); }
    const float nscale = -0.08838834764831845f * 1.4426950408889634f;
    f32x16 o[4];
#pragma unroll
    for (int dt = 0; dt < 4; ++dt)
#pragma unroll
        for (int i = 0; i < 16; ++i) o[dt][i] = 0.f;
    float Pc = 1.0f;
    bf16x8 kf[8];
    { const bf16* kp = K2 + ((size_t)((bh * 128 + qb) * 8) * 64 + lane) * 8;
#pragma unroll
      for (int s = 0; s < 8; ++s) kf[s] = *(const bf16x8*)(kp + (size_t)s * 512); }
    for (int kb = qb; kb >= 0; --kb) {
        bf16x8 vf[4][2];
        { const bf16* vp = V3 + ((size_t)((bh * 128 + kb) * 8) * 64 + lane) * 8;
#pragma unroll
          for (int dt = 0; dt < 4; ++dt)
#pragma unroll
              for (int s = 0; s < 2; ++s) vf[dt][s] = *(const bf16x8*)(vp + (size_t)(dt * 2 + s) * 512); }
        bf16x8 kn[8];
        { const int kbn = kb > 0 ? kb - 1 : 0; const bf16* kp = K2 + ((size_t)((bh * 128 + kbn) * 8) * 64 + lane) * 8;
#pragma unroll
          for (int s = 0; s < 8; ++s) kn[s] = *(const bf16x8*)(kp + (size_t)s * 512); }
        f32x16 st;
#pragma unroll
        for (int i = 0; i < 16; ++i) st[i] = 0.f;
#pragma unroll
        for (int s = 0; s < 8; ++s) st = __builtin_amdgcn_mfma_f32_32x32x16_bf16(kf[s], qf[s], st, 0, 0, 0);
        const bool diag = (kb == qb);
        float bv[16], nv[16], gp[4];
#pragma unroll
        for (int g = 0; g < 4; ++g) { float pg_ = 1.f;
#pragma unroll
            for (int u = 0; u < 4; ++u) { const int i = 4 * g + u; const float z = st[i];
                const bool valid = !diag || ((u + 8 * g + 4 * hh) < r);
                const float e = __builtin_amdgcn_exp2f(fabsf(z) * nscale);
                const float t = __builtin_amdgcn_rcpf(1.0f + e), et = e * t;
                const float beta = z >= 0.f ? t : et, nn = z >= 0.f ? et : t;
                bv[i] = valid ? beta : 0.f; nv[i] = valid ? nn : 1.f; pg_ *= nv[i]; }
            gp[g] = pg_; }
        float pp[4];
#pragma unroll
        for (int g = 0; g < 4; ++g) pp[g] = other_half(gp[g], hh);
        float tail[4]; float run = 1.f;
#pragma unroll
        for (int g = 3; g >= 0; --g) { tail[g] = run * (hh == 0 ? pp[g] : 1.f); run *= gp[g] * pp[g]; }
        unsigned pw[8];
#pragma unroll
        for (int g = 0; g < 4; ++g) { float a[4]; float suf = Pc * tail[g];
#pragma unroll
            for (int u = 3; u >= 0; --u) { const int i = 4 * g + u; a[u] = bv[i] * suf; suf *= nv[i]; }
            pw[2 * g] = pk2(a[0], a[1]); pw[2 * g + 1] = pk2(a[2], a[3]); }
        Pc *= run;
        bf16x8 pf[2];
        { v4u t0 = {pw[0], pw[1], pw[2], pw[3]}, t1 = {pw[4], pw[5], pw[6], pw[7]}; pf[0] = __builtin_bit_cast(bf16x8, t0); pf[1] = __builtin_bit_cast(bf16x8, t1); }
#pragma unroll
        for (int dt = 0; dt < 4; ++dt)
#pragma unroll
            for (int s = 0; s < 2; ++s) o[dt] = __builtin_amdgcn_mfma_f32_32x32x16_bf16(vf[dt][s], pf[s], o[dt], 0, 0, 0);
        if (__builtin_amdgcn_ballot_w64(Pc != 0.0f) == 0ull) break;
#pragma unroll
        for (int s = 0; s < 8; ++s) kf[s] = kn[s];
    }
    bf16* yrow = Y + (tok0 + q0 + r) * 1024 + h * 128 + 4 * hh;
#pragma unroll
    for (int dt = 0; dt < 4; ++dt)
#pragma unroll
        for (int g = 0; g < 4; ++g) { v2u w; w.x = pk2(o[dt][4 * g], o[dt][4 * g + 1]); w.y = pk2(o[dt][4 * g + 2], o[dt][4 * g + 3]); *(v2u*)(yrow + 32 * dt + 8 * g) = w; }
}

template <int W> __device__ __forceinline__ void pool_window(const bf16* up, bf16* dst, int s) {
    v4u rows[W];
#pragma unroll
    for (int j = 0; j < W; ++j) rows[j] = *(const v4u*)(up - (size_t)((j <= s) ? j : 0) * 1024);
    float sm[8] = {0.f, 0.f, 0.f, 0.f, 0.f, 0.f, 0.f, 0.f};
#pragma unroll
    for (int j = 0; j < W; ++j) { const float m = (j <= s) ? 1.0f : 0.0f; const v4u u = rows[j];
        sm[0] += m * bflo(u.x); sm[1] += m * bfhi(u.x); sm[2] += m * bflo(u.y); sm[3] += m * bfhi(u.y); sm[4] += m * bflo(u.z); sm[5] += m * bfhi(u.z); sm[6] += m * bflo(u.w); sm[7] += m * bfhi(u.w); }
    const int cnt = (s + 1) < W ? (s + 1) : W; const float inv = 1.0f / (float)cnt; const v4u u0 = rows[0];
    v4u o; o.x = pk2(sm[0] * inv - bflo(u0.x), sm[1] * inv - bfhi(u0.x)); o.y = pk2(sm[2] * inv - bflo(u0.y), sm[3] * inv - bfhi(u0.y));
    o.z = pk2(sm[4] * inv - bflo(u0.z), sm[5] * inv - bfhi(u0.z)); o.w = pk2(sm[6] * inv - bflo(u0.w), sm[7] * inv - bfhi(u0.w));
    *(v4u*)dst = o;
}

constexpr int NPH = 20;
__device__ __forceinline__ int lau(int x) { asm volatile("" : "+s"(x)); return x; }
__device__ __forceinline__ int lauv(int x) { asm volatile("" : "+v"(x)); return x; }
__device__ __forceinline__ void moe_tile_starts(const unsigned* ecnt, int (&ts)[9]) {
    asm volatile("" : "+s"(ecnt));
    ts[0] = 0;
#pragma unroll
    for (int e = 0; e < 8; ++e) { const int c = (int)__builtin_amdgcn_readfirstlane(__hip_atomic_load(ecnt + 64 * e, RLX_AGENT)); ts[e + 1] = ts[e] + ((c + 255) >> 8); }
}

#if MK_PER_PHASE
#define GRID_BAR() do { } while (0)
#else
#define GRID_BAR() xcd_barrier(bar)
#endif
#define IN(k) (lo <= (k) && (k) < hi)
#define SEAM(k) do { if (IN(k) && IN((k) + 1)) GRID_BAR(); } while (0)
#define WSP(T, off) ((T*)(A->ws + (off)))
#define PH_LOCALS() const int wave = lau(wave0), lane = pg8::lane_id_now(), tid = wave * 64 + lane, gw = lau(gw0); (void)tid; (void)lane; (void)wave; (void)gw
constexpr int HK_NBAL = N_STRIPS % 256, HK_BAL_TILES = (256 - HK_NBAL) * 16;
constexpr int HK_D0 = SEG_D0 + 2 * POOL_CVT + 2 * PROJ_CVT + FGU_CVT + HK_BAL_TILES;
constexpr int HKN_PROJ = (HK_MASK & 1) ? HK_TPU * 1024 : 0, HKN_MRG = (HK_MASK & 2) ? HK_TPU * 256 : 0, HKN_OUT = (HK_MASK & 4) ? HK_TPU * 256 : 0, HKN_FGU = (HK_MASK & 8) ? HK_TPU * 1408 : 0, HKN_FD = (HK_MASK & 16) ? HK_TPU * 256 : 0;
constexpr int FGU_STG = (STG_MASK & 8) ? (FGU_G / 2) * NWAVES * 6 + 672 : 0;
constexpr int PROJ_STGB = (STG_MASK & 1) ? 4096 : 0, PROJ_STGA = (STG_MASK & 1) ? 4096 : 0;
constexpr int HK_PROJ0 = HK_D0, HK_PS0 = HK_PROJ0 + HKN_PROJ, HK_E1_0 = HK_PS0 + PROJ_STGB + PROJ_STGA, HK_E2_0 = HK_E1_0 + HKN_MRG, HK_OUT0 = HK_E2_0 + HKN_MRG, HK_FGU = HK_OUT0 + HKN_OUT, HK_FGUS = HK_FGU + HKN_FGU,
              HK_FD = HK_FGUS + 2 * FGU_STG, HK_PROJ1 = HK_FD + HKN_FD, HK_PS1 = HK_PROJ1 + HKN_PROJ, HK_E1_1 = HK_PS1 + PROJ_STGB + PROJ_STGA, HK_E2_1 = HK_E1_1 + HKN_MRG, HK_OUT1 = HK_E2_1 + HKN_MRG,
              HK_DEND = HK_OUT1 + HKN_OUT;
static_assert(HK_DEND <= SEG_E0, "hook plan inside SEG_D");
template <int BIT> __device__ __forceinline__ CvtHookT<(HK_MASK & BIT) != 0> hook_range(bool on, int first, int count) { CvtHookT<(HK_MASK & BIT) != 0> h; h.first = first; h.last = on ? first + count : first; return h; }
template <int L> __device__ __forceinline__ void layer_phases(LAS unsigned char* lds, const int G, const int bx, const int vcu, const int gw0, const int wave0, const int NGW, const int lo, const int hi, const XcdBarrier bar) {
    constexpr int l = L;
        const int pb = 1 + 9 * l;
        if (IN(pb + 0)) {
            ArgsP A = argp();
            pg8::StaticOrder<M / 256, INC / 256, D / 2, D / 2, 0> S{lau(G), lau(bx)};
            pg8::EpiProj E{WSP(bf16, WS_UPOOL), WSP(bf16, WS_Q), WSP(bf16, WS_K), WSP(bf16, WS_VT), WSP(bf16, WS_GATES), WSP(const float, WS_TOK + 262144), WSP(const unsigned, WS_CTL) + CW_COLMAX_WIN + l * INC};
            const auto HK = hook_range<1>(G == 256, l == 0 ? HK_PROJ0 : HK_PROJ1, HKN_PROJ);
            if (G == 256 && PROJ_STGB > 0 && !(bx & 1)) {
                PH_LOCALS(); const int ps = l == 0 ? HK_PS0 : HK_PS1;
                cvt_range_big(A, SEG_D0 + 2 * POOL_CVT + l * PROJ_CVT, SEG_D0 + 2 * POOL_CVT + (l + 1) * PROJ_CVT, (bx >> 1) * NWAVES + wave, 128 * NWAVES, lane);
                cvt_range_big(A, ps, ps + PROJ_STGB, (bx >> 1) * NWAVES + wave, 128 * NWAVES, lane);
                if (l == 0) cvt_range(A, SEG_A0 + T_WIN, SEG_B0, (bx >> 1) * NWAVES + wave, 128 * NWAVES, lane); }
            pg8::gemm_phase<D / 2, D / 2, D / 2, pg8::EpiProj, decltype(S), true, false, 2, false, decltype(HK)>(lds + RING_OFF, WSP(const bf16, WS_H), WSP(const bf16, WS_WIN) + (size_t)l * INC * D, S, E, lau(wave0), HK);
            if (G == 256 && PROJ_STGB > 0) { if (bx & 1) { PH_LOCALS(); const int ps = (l == 0 ? HK_PS0 : HK_PS1) + PROJ_STGB;
                    cvt_range_big(A, ps, ps + PROJ_STGA, (bx >> 1) * NWAVES + wave, 128 * NWAVES, lane);
                    if (l == 0) { if (DENSE_DOWN_FP8) cvt_range_big(A, SEG_B0 + 2 * T_FF8, SEG_B0 + 3 * T_FF8, (bx >> 1) * NWAVES + wave, 128 * NWAVES, lane); else cvt_range(A, SEG_B0 + 2 * T_FF8, SEG_C0, (bx >> 1) * NWAVES + wave, 128 * NWAVES, lane); } } }
            else if (G == 256 && !(bx & 1)) {
                PH_LOCALS(); cvt_range_big(A, SEG_D0 + 2 * POOL_CVT + l * PROJ_CVT, SEG_D0 + 2 * POOL_CVT + (l + 1) * PROJ_CVT, (bx >> 1) * NWAVES + wave, 128 * NWAVES, lane); }
        }
        SEAM(pb + 0);
        if (IN(pb + 1)) {
            ArgsP A = argp(); PH_LOCALS();
            const bf16 *Qb = WSP(const bf16, WS_Q), *Kb = WSP(const bf16, WS_K), *VT = WSP(const bf16, WS_VT); bf16* YATTN = WSP(bf16, WS_YATTN);
            for (int rep = 0; rep < ((PROBE_DUP & 2) ? 2 : 1); ++rep) {
            for (int it = gw; it < 2048; it += NGW) {
                const int blk = it >> 3, w = it & 7, bh = blk >> 4, i = blk & 15;
                const int qb = (w < 4) ? (4 * i + w) : (127 - (4 * i + (w - 4)));
                attn_item(Qb, Kb, VT, YATTN, bh >> 3, bh & 7, qb, lane);
            }
            const bf16* UPOOL = WSP(const bf16, WS_UPOOL); bf16* POOLED = WSP(bf16, WS_POOLED);
            for (int wi = gw; wi < 2 * M; wi += NGW) {
                const int g = ((wi & 3) + wi / NGW) & 3, pair = wi >> 2;
                const int tok = 2 * pair + (lane >> 5), cc = 32 * g + (lane & 31), s = tok & (SEQ - 1);
                const bf16* up = UPOOL + (size_t)tok * 1024 + cc * 8;
                if (g == 0) pool_window<2>(up, POOLED + (size_t)tok * 1024 + cc * 8, s);
                else if (g == 1) pool_window<4>(up, POOLED + (size_t)tok * 1024 + cc * 8, s);
                else if (g == 2) pool_window<8>(up, POOLED + (size_t)tok * 1024 + cc * 8, s);
                else pool_window<16>(up, POOLED + (size_t)tok * 1024 + cc * 8, s);
            }
            }
        }
        SEAM(pb + 1);
        if (IN(pb + 2)) {
            ArgsP A = argp();
            if (G == 256 && bx >= 128) {
                PH_LOCALS(); cvt_range_big(A, SEG_D0 + l * POOL_CVT, SEG_D0 + (l + 1) * POOL_CVT, (bx - 128) * NWAVES + wave, 128 * NWAVES, lane); }
            pg8::StaticOrder<M / 256, 4, PW, 256, 512> S{lau(G), lau(bx)};
            pg8::EpiPool E{WSP(bf16, WS_YPOOL), A->in[4] + (size_t)l * PW};
            pg8::gemm_phase<PW, 256, 256>(lds + RING_OFF, WSP(const bf16, WS_POOLED), WSP(const bf16, WS_POOLW) + (size_t)l * 4 * 65536, S, E, lau(wave0));
        }
        SEAM(pb + 2);
        if (IN(pb + 3)) {
            { ArgsP A = argp(); pg8::StaticOrder<M / 256, D / 256, PW, PW, 0> S{lau(G), lau(bx)};
              pg8::EpiGate<1> E{WSP(const bf16, WS_GATES), WSP(bf16, WS_T), WSP(bf16, WS_MERGED)};
              pg8::gemm_phase<PW, PW, PW>(lds + RING_OFF, WSP(const bf16, WS_YPOOL), WSP(const bf16, WS_WPU) + (size_t)l * D * PW, S, E, lau(wave0), hook_range<2>(G == 256, l == 0 ? HK_E1_0 : HK_E1_1, HKN_MRG)); }
            { ArgsP A = argp(); pg8::StaticOrder<M / 256, D / 256, PW, PW, 0> S{lau(G), lau(bx)};
              pg8::EpiGate<2> E{WSP(const bf16, WS_GATES), WSP(bf16, WS_T), WSP(bf16, WS_MERGED)};
              pg8::gemm_phase<PW, PW, PW>(lds + RING_OFF, WSP(const bf16, WS_YATTN), WSP(const bf16, WS_WAU) + (size_t)l * D * PW, S, E, lau(wave0), hook_range<2>(G == 256, l == 0 ? HK_E2_0 : HK_E2_1, HKN_MRG)); }
        }
        SEAM(pb + 3);
        if (IN(pb + 4)) {
            ArgsP A = argp();
            pg8::StaticOrder<M / 256, D / 256, D, D, 0> S{lau(G), lau(bx)};
            pg8::EpiResid E{l == 0 ? A->in[0] : WSP(const float, WS_X), WSP(float, WS_X), 1.0f};
            pg8::gemm_phase<D, D, D>(lds + RING_OFF, WSP(const bf16, WS_MERGED), WSP(const bf16, WS_WOUT) + (size_t)l * D * D, S, E, lau(wave0), hook_range<4>(G == 256, l == 0 ? HK_OUT0 : HK_OUT1, HKN_OUT));
        }
        SEAM(pb + 4);
        if (l == 0) {
            if (IN(pb + 5)) { ArgsP A = argp(); PH_LOCALS(); const float* X = WSP(const float, WS_X); const float* gn = A->in[8];
                for (int m = gw; m < M; m += 4 * NGW) rms_rows_to_i8<4>(X, gn, WSP(unsigned char, WS_H), WSP(float, WS_TOK + 262144), m, NGW, lane);
}
            SEAM(pb + 5);
            if (IN(pb + 6)) {
                ArgsP A = argp();
                if (G == 256 && bx >= FGU_G) {
                    PH_LOCALS(); const int widx = (bx - FGU_G) * NWAVES + wave, nw = (256 - FGU_G) * NWAVES;
                    cvt_range(A, SEG_C0 + T_WIN, SEG_D0, widx, nw, lane);
                    cvt_range_big(A, SEG_D0 + 2 * POOL_CVT + 2 * PROJ_CVT, SEG_D0 + 2 * POOL_CVT + 2 * PROJ_CVT + FGU_CVT, widx, nw, lane);
                } else {
                    pg8::StaticOrder<M / 256, 2 * DFF / 256, D / 2, D / 2, 0> S{lau(G == 256 ? FGU_G : G), lau(bx)};
                    pg8::EpiSwiGLUi8 E{WSP(bf16, WS_G), WSP(const float, WS_TOK + 262144), WSP(const unsigned, WS_CTL) + CW_COLMAX};
                    if (G == 256 && FGU_STG > 0 && (bx & 1)) { PH_LOCALS(); cvt_range_big(A, HK_FGUS, HK_FGUS + FGU_STG, (bx >> 1) * NWAVES + wave, (FGU_G / 2) * NWAVES, lane); }
                    pg8::gemm_phase<D / 2, D / 2, D / 2, pg8::EpiSwiGLUi8, decltype(S), true, false, 2, false, CvtHookT<(HK_MASK & 8) != 0>>(lds + RING_OFF, WSP(const bf16, WS_H), WSP(const bf16, WS_FGU), S, E, lau(wave0), hook_range<8>(G == 256, HK_FGU, HKN_FGU));
                    if (G == 256 && FGU_STG > 0 && !(bx & 1)) { PH_LOCALS(); cvt_range_big(A, HK_FGUS + FGU_STG, HK_FGUS + 2 * FGU_STG, (bx >> 1) * NWAVES + wave, (FGU_G / 2) * NWAVES, lane); }
                }
            }
            SEAM(pb + 6);
            if (IN(pb + 7)) {
                ArgsP A = argp();
                pg8::StaticOrder<M / 256, D / 256, DFF, DFF, 0> S{lau(G), lau(bx)};
#if DENSE_DOWN_FP8
                pg8::StaticOrder<M / 256, D / 256, DFF / 2, DFF / 2, 0> S8{lau(G), lau(bx)};
                pg8::EpiResid E{WSP(const float, WS_X), WSP(float, WS_X), 1.0f / (pg8::FP8_W_SCALE * pg8::FP8_G_SCALE)};
                pg8::gemm_phase<DFF / 2, DFF / 2, DFF / 2, pg8::EpiResid, decltype(S8), true, false, 1>(lds + RING_OFF, WSP(const bf16, WS_G), WSP(const bf16, WS_FD), S8, E, lau(wave0));
#else
                pg8::EpiResid E{WSP(const float, WS_X), WSP(float, WS_X), 1.0f};
                pg8::gemm_phase<DFF, DFF, DFF>(lds + RING_OFF, WSP(const bf16, WS_G), WSP(const bf16, WS_FD), S, E, lau(wave0), hook_range<16>(G == 256, HK_FD, HKN_FD));
#endif
            }
            SEAM(pb + 7);
            if (IN(pb + 8)) { ArgsP A = argp(); PH_LOCALS(); const float* X = WSP(const float, WS_X); const float* gn = A->in[1] + D;
                for (int m = gw; m < M; m += 4 * NGW) rms_rows_to_i8<4>(X, gn, WSP(unsigned char, WS_H), WSP(float, WS_TOK + 262144), m, NGW, lane); }
            SEAM(pb + 8);
        } else {
            if (IN(pb + 5)) {
                ArgsP A = argp(); PH_LOCALS();
                const float* X = WSP(const float, WS_X); bf16* H = WSP(bf16, WS_H);
                unsigned* ecnt = WSP(unsigned, WS_CTL) + CW_ECNT;
                int* TOKE = WSP(int, WS_TOK); int* TOKP = WSP(int, WS_TOK + 65536); float* TOKW = WSP(float, WS_TOK + 131072); int* INV = WSP(int, WS_CTL) + CW_INV;
                LAS int* lcnt = (LAS int*)(lds + RING_OFF);
                LAS int* lbase = lcnt + 8; LAS int* sel = lcnt + 16;
                const float* gain = A->in[8] + D; const float* wr = A->in[12];
                for (int ch = vcu; ch < M / 32; ch += G) {
                    if (tid < 8) lcnt[tid] = 0;
                    __syncthreads();
                    for (int half = 0; half < 2; ++half) {
                        f32x4 v[2][8]; float rs[2];
#pragma unroll
                        for (int i = 0; i < 2; ++i) { const f32x4* xr = (const f32x4*)(X + (size_t)(ch * 32 + wave * 4 + 2 * half + i) * D) + lane;
#pragma unroll
                            for (int j = 0; j < 8; ++j) v[i][j] = xr[64 * j]; }
#pragma unroll
                        for (int i = 0; i < 2; ++i) { float s = 0.f;
#pragma unroll
                            for (int j = 0; j < 8; ++j) s += (v[i][j].x * v[i][j].x + v[i][j].y * v[i][j].y) + (v[i][j].z * v[i][j].z + v[i][j].w * v[i][j].w);
                            rs[i] = 1.0f / sqrtf(wave_sum(s) * (1.f / D) + RMS_EPS); }
                        float lg[2][8];
#pragma unroll
                        for (int i = 0; i < 2; ++i)
#pragma unroll
                            for (int e = 0; e < 8; ++e) lg[i][e] = 0.f;
                        const f32x4* gr = (const f32x4*)gain + lane;
#pragma unroll
                        for (int j = 0; j < 8; ++j) { const f32x4 g = gr[64 * j];
#pragma unroll
                            for (int i = 0; i < 2; ++i) { f32x4 hn; hn.x = v[i][j].x * rs[i] * g.x; hn.y = v[i][j].y * rs[i] * g.y; hn.z = v[i][j].z * rs[i] * g.z; hn.w = v[i][j].w * rs[i] * g.w; v[i][j] = hn;
                                ((unsigned*)((unsigned char*)H + (size_t)(ch * 32 + wave * 4 + 2 * half + i) * D) + lane)[64 * j] = pg8::pk4_fp8(hn.x * pg8::FP8_H_SCALE, hn.y * pg8::FP8_H_SCALE, hn.z * pg8::FP8_H_SCALE, hn.w * pg8::FP8_H_SCALE); }
                            const f32x4* wp = (const f32x4*)(wr + (size_t)(4 * (lane + 64 * j)) * 8);
#pragma unroll
                            for (int c = 0; c < 4; ++c) { const f32x4 w0 = wp[2 * c], w1 = wp[2 * c + 1];
#pragma unroll
                                for (int i = 0; i < 2; ++i) { const float hv = v[i][j][c];
                                    lg[i][0] += hv * w0.x; lg[i][1] += hv * w0.y; lg[i][2] += hv * w0.z; lg[i][3] += hv * w0.w; lg[i][4] += hv * w1.x; lg[i][5] += hv * w1.y; lg[i][6] += hv * w1.z; lg[i][7] += hv * w1.w; } }
                            asm volatile("" : "+v"(lg[0][0]), "+v"(lg[0][1]), "+v"(lg[0][2]), "+v"(lg[0][3]), "+v"(lg[0][4]), "+v"(lg[0][5]), "+v"(lg[0][6]), "+v"(lg[0][7]),
                                              "+v"(lg[1][0]), "+v"(lg[1][1]), "+v"(lg[1][2]), "+v"(lg[1][3]), "+v"(lg[1][4]), "+v"(lg[1][5]), "+v"(lg[1][6]), "+v"(lg[1][7]) :: "memory"); }
#pragma unroll
                        for (int i = 0; i < 2; ++i) { const int tl = wave * 4 + 2 * half + i;
#pragma unroll
                            for (int e = 0; e < 8; ++e) lg[i][e] = wave_sum(lg[i][e]);
                            int e1 = 0; float v1 = lg[i][0];
#pragma unroll
                            for (int e = 1; e < 8; ++e) if (lg[i][e] > v1) { v1 = lg[i][e]; e1 = e; }
                            int e2 = -1; float v2 = -3.0e38f;
#pragma unroll
                            for (int e = 0; e < 8; ++e) if (e != e1 && lg[i][e] > v2) { v2 = lg[i][e]; e2 = e; }
                            if (lane == 0) { const float w1 = 1.0f / (1.0f + expf(v2 - v1));
                                const int p1 = __hip_atomic_fetch_add(lcnt + e1, 1, __ATOMIC_RELAXED, __HIP_MEMORY_SCOPE_WORKGROUP), p2 = __hip_atomic_fetch_add(lcnt + e2, 1, __ATOMIC_RELAXED, __HIP_MEMORY_SCOPE_WORKGROUP);
                                sel[tl * 6 + 0] = e1; sel[tl * 6 + 1] = e2; sel[tl * 6 + 2] = p1; sel[tl * 6 + 3] = p2; ((LAS float*)sel)[tl * 6 + 4] = w1; ((LAS float*)sel)[tl * 6 + 5] = 1.0f - w1; } }
                    }
                    __syncthreads();
                    if (tid < 8) lbase[tid] = (int)__hip_atomic_fetch_add(ecnt + 64 * tid, (unsigned)lcnt[tid], RLX_AGENT);
                    __syncthreads();
                    if (tid < 32) { const int tok = ch * 32 + tid; const int e1 = sel[tid * 6], e2 = sel[tid * 6 + 1];
                        TOKE[2 * tok] = e1; TOKE[2 * tok + 1] = e2; TOKP[2 * tok] = lbase[e1] + sel[tid * 6 + 2]; TOKP[2 * tok + 1] = lbase[e2] + sel[tid * 6 + 3];
                        INV[e1 * 8192 + lbase[e1] + sel[tid * 6 + 2]] = tok; INV[e2 * 8192 + lbase[e2] + sel[tid * 6 + 3]] = tok;
                        TOKW[2 * tok] = ((LAS float*)sel)[tid * 6 + 4]; TOKW[2 * tok + 1] = ((LAS float*)sel)[tid * 6 + 5]; }
                    __syncthreads();
                }
            }
            SEAM(pb + 5);
            if (IN(pb + 7)) {
                ArgsP A = argp();
                pg8::MoeOrder<2 * DFF / 256, D / 2, D / 2, (size_t)2 * DFF * D> S; moe_tile_starts(WSP(const unsigned, WS_CTL) + CW_ECNT, S.ts); S.inv = WSP(const int, WS_CTL) + CW_INV;
                const int units = S.ts[8] * (2 * DFF / 256), rounds = (units + G - 1) / G; int Gg = ((units + rounds - 1) / rounds + 7) & ~7; if (Gg > G || (G & 7)) Gg = G;
                const bool hk = (G == 256);
                int hkn = (hk && (HK_MASK & 32)) ? HK_TPU * units : 0; if (hkn > 8 * T_FF8) hkn = 8 * T_FF8;
                if (hk) Gg = G;
                int stg = hk ? MOE_STG : 0; if (2 * stg > 8 * T_FF8 - hkn) stg = (8 * T_FF8 - hkn) / 2;
                const int ncv = G - Gg; int q17 = ncv * rounds * CONV_TILES_PER_CU_ROUND_F8; if (q17 > 8 * T_FF8 - hkn - 2 * stg) q17 = 8 * T_FF8 - hkn - 2 * stg;
                CvtHookT<(HK_MASK & 32) != 0> HK; HK.first = SEG_E0; HK.last = SEG_E0 + hkn;
                if (bx >= Gg) { PH_LOCALS(); cvt_range_big(A, SEG_E0 + hkn + 2 * stg, SEG_E0 + hkn + 2 * stg + q17, (bx - Gg) * NWAVES + wave, ncv * NWAVES, lane); }
                else { S.G = lau(Gg); S.c = lau((bx % 8) * (Gg / 8) + bx / 8);
                    if (stg > 0 && (bx & 1)) { PH_LOCALS(); cvt_range_big(A, SEG_E0 + hkn, SEG_E0 + hkn + stg, (bx >> 1) * NWAVES + wave, 128 * NWAVES, lane); }
                    pg8::EpiSwiGLU8 E{WSP(unsigned char, WS_G)};
                    pg8::gemm_phase<D / 2, D / 2, D / 2, pg8::EpiSwiGLU8, decltype(S), true, false, 1, true, decltype(HK)>(lds + RING_OFF, WSP(const bf16, WS_H), WSP(const bf16, WS_MGU), S, E, lau(wave0), HK);
                    if (stg > 0 && !(bx & 1)) { PH_LOCALS(); cvt_range_big(A, SEG_E0 + hkn + stg, SEG_E0 + hkn + 2 * stg, (bx >> 1) * NWAVES + wave, 128 * NWAVES, lane); } }
                { PH_LOCALS(); cvt_range_big(A, SEG_E0 + hkn + 2 * stg + q17, CVT_TILES, gw, NGW, lane); }
            }
            SEAM(pb + 7);
            if (IN(pb + 8)) {
                ArgsP A = argp();
                pg8::TailSplitOrder<D / 256, DFF / 2, DFF / 2, DFF / 256, (size_t)D * DFF> S; S.G = lau(G); S.c = lau(vcu); moe_tile_starts(WSP(const unsigned, WS_CTL) + CW_ECNT, S.ts);
                pg8::EpiPart E{WSP(bf16, WS_Y), WSP(bf16, WS_Y2), 1.0f / (pg8::FP8_W_SCALE * pg8::FP8_G_SCALE)};
                pg8::gemm_phase<DFF / 2, DFF / 2, DFF / 2, pg8::EpiPart, decltype(S), true, true, true>(lds + RING_OFF, WSP(const bf16, WS_G), WSP(const bf16, WS_MD), S, E, lau(wave0));
            }
            SEAM(pb + 8);
            if (IN(pb + 9)) {
                ArgsP A = argp(); PH_LOCALS();
                int ts[9]; moe_tile_starts(WSP(const unsigned, WS_CTL) + CW_ECNT, ts);
                const int* TOKE = WSP(const int, WS_TOK); const int* TOKP = WSP(const int, WS_TOK + 65536); const float* TOKW = WSP(const float, WS_TOK + 131072);
                const float* X = WSP(const float, WS_X); const bf16* Yb = WSP(const bf16, WS_Y); const bf16* Y2 = WSP(const bf16, WS_Y2); const float* gfin = A->in[16]; float* out = A->out;
                const f32x4* gr = (const f32x4*)gfin + 2 * lane;
                int tF, tR, tsp; { pg8::TailSplitOrder<D / 256, DFF / 2, DFF / 2, DFF / 256, (size_t)D * DFF> TS; TS.G = G; TS.c = 0;
#pragma unroll
                    for (int e = 0; e < 9; ++e) TS.ts[e] = ts[e];
                    TS.tail_split(tF, tR, tsp); (void)tR; }
                for (int t0 = gw; t0 < M; t0 += 2 * NGW) {
                    size_t r1[2], r2[2]; float w1[2], w2[2]; int tk[2]; int lb[2][2], lt[2][2], rit[2][2];
#pragma unroll
                    for (int q = 0; q < 2; ++q) { const int tok = (t0 + q * NGW) < M ? (t0 + q * NGW) : t0; tk[q] = tok;
                        const int e1 = TOKE[2 * tok], e2 = TOKE[2 * tok + 1], p1 = TOKP[2 * tok], p2 = TOKP[2 * tok + 1];
                        w1[q] = TOKW[2 * tok]; w2[q] = TOKW[2 * tok + 1];
                        int o1 = 0, o2 = 0, n1 = 0, n2 = 0;
#pragma unroll
                        for (int e = 0; e < 8; ++e) { if (e == e1) { o1 = ts[e]; n1 = ts[e + 1]; } if (e == e2) { o2 = ts[e]; n2 = ts[e + 1]; } }
                        r1[q] = (size_t)(o1 * 256 + p1) * D; r2[q] = (size_t)(o2 * 256 + p2) * D;
                        lb[q][0] = o1 * 8 + (p1 >> 8); lt[q][0] = n1 - o1; rit[q][0] = p1 & 255; lb[q][1] = o2 * 8 + (p2 >> 8); lt[q][1] = n2 - o2; rit[q][1] = p2 & 255; }
                    v4u ya[2][4][4]; f32x4 v[2][8];
#pragma unroll
                    for (int q = 0; q < 2; ++q) { const f32x4* xr = (const f32x4*)(X + (size_t)tk[q] * D) + 2 * lane;
                        const v4u* ya1 = (const v4u*)(Yb + r1[q]) + lane; const v4u* yb1 = (const v4u*)(Y2 + r1[q]) + lane; const v4u* ya2 = (const v4u*)(Yb + r2[q]) + lane; const v4u* yb2 = (const v4u*)(Y2 + r2[q]) + lane;
#pragma unroll
                        for (int jj = 0; jj < 4; ++jj) { ya[q][jj][0] = ya1[64 * jj]; ya[q][jj][2] = ya2[64 * jj]; if (MOE_DOWN_KSPLIT == 2) { ya[q][jj][1] = yb1[64 * jj]; ya[q][jj][3] = yb2[64 * jj]; } else { ya[q][jj][1] = (v4u){0u, 0u, 0u, 0u}; ya[q][jj][3] = (v4u){0u, 0u, 0u, 0u}; } v[q][2 * jj] = xr[128 * jj]; v[q][2 * jj + 1] = xr[128 * jj + 1]; } }
                    if (tsp > 1) {
#pragma unroll
                        for (int q = 0; q < 2; ++q)
#pragma unroll
                            for (int sl = 0; sl < 2; ++sl)
#pragma unroll
                                for (int jj = 0; jj < 4; ++jj) { const int Lu = lb[q][sl] + (2 * jj + (lane >> 5)) * lt[q][sl];
                                    if (Lu >= tF) { float a8[8] = {0.f, 0.f, 0.f, 0.f, 0.f, 0.f, 0.f, 0.f};
                                        const bf16* sp_ = Y2 + ((size_t)((Lu - tF) * tsp) * 256 + rit[q][sl]) * 256 + 8 * (lane & 31);
                                        for (int p = 0; p < tsp; ++p) { const v4u t = *(const v4u*)(sp_ + (size_t)p * 65536);
                                            a8[0] += bflo(t.x); a8[1] += bfhi(t.x); a8[2] += bflo(t.y); a8[3] += bfhi(t.y); a8[4] += bflo(t.z); a8[5] += bfhi(t.z); a8[6] += bflo(t.w); a8[7] += bfhi(t.w); }
                                        v4u pk; pk.x = pk2(a8[0], a8[1]); pk.y = pk2(a8[2], a8[3]); pk.z = pk2(a8[4], a8[5]); pk.w = pk2(a8[6], a8[7]);
                                        ya[q][jj][2 * sl] = (v4u){0u, 0u, 0u, 0u}; ya[q][jj][2 * sl + 1] = pk; } }
                    }
#pragma unroll
                    for (int q = 0; q < 2; ++q) { float s = 0.f;
#pragma unroll
                        for (int jj = 0; jj < 4; ++jj) { const v4u a1 = ya[q][jj][0], b1 = ya[q][jj][1], a2 = ya[q][jj][2], b2 = ya[q][jj][3]; const float u1 = w1[q], u2 = w2[q];
                            f32x4 m0, m1;
                            m0.x = u1 * (bflo(a1.x) + bflo(b1.x)) + u2 * (bflo(a2.x) + bflo(b2.x)); m0.y = u1 * (bfhi(a1.x) + bfhi(b1.x)) + u2 * (bfhi(a2.x) + bfhi(b2.x));
                            m0.z = u1 * (bflo(a1.y) + bflo(b1.y)) + u2 * (bflo(a2.y) + bflo(b2.y)); m0.w = u1 * (bfhi(a1.y) + bfhi(b1.y)) + u2 * (bfhi(a2.y) + bfhi(b2.y));
                            m1.x = u1 * (bflo(a1.z) + bflo(b1.z)) + u2 * (bflo(a2.z) + bflo(b2.z)); m1.y = u1 * (bfhi(a1.z) + bfhi(b1.z)) + u2 * (bfhi(a2.z) + bfhi(b2.z));
                            m1.z = u1 * (bflo(a1.w) + bflo(b1.w)) + u2 * (bflo(a2.w) + bflo(b2.w)); m1.w = u1 * (bfhi(a1.w) + bfhi(b1.w)) + u2 * (bfhi(a2.w) + bfhi(b2.w));
                            v[q][2 * jj] += m0; v[q][2 * jj + 1] += m1; }
#pragma unroll
                        for (int j = 0; j < 8; ++j) s += (v[q][j].x * v[q][j].x + v[q][j].y * v[q][j].y) + (v[q][j].z * v[q][j].z + v[q][j].w * v[q][j].w);
                        const float rstd = 1.0f / sqrtf(wave_sum(s) * (1.f / D) + RMS_EPS);
                        if (q == 0 || (t0 + NGW) < M) { f32x4* orow = (f32x4*)(out + (size_t)tk[q] * D) + 2 * lane;
#pragma unroll
                            for (int jj = 0; jj < 4; ++jj)
#pragma unroll
                                for (int hf = 0; hf < 2; ++hf) { const f32x4 g = gr[128 * jj + hf]; const f32x4 x = v[q][2 * jj + hf]; f32x4 o; o.x = x.x * rstd * g.x; o.y = x.y * rstd * g.y; o.z = x.z * rstd * g.z; o.w = x.w * rstd * g.w; orow[128 * jj + hf] = o; } } }
                }
            }
        }
}

__global__ void __launch_bounds__(NWAVES * 64, 2) fwd_kernel(Args args_unused) {
    extern __shared__ __attribute__((aligned(16))) unsigned char lds_raw[];
    LAS unsigned char* lds = (LAS unsigned char*)lds_raw;
    volatile LAS unsigned* MISC = (volatile LAS unsigned*)(lds + MISC_OFF);
    const int tid0 = threadIdx.x, wave0 = __builtin_amdgcn_readfirstlane(tid0 >> 6);
    const int G = gridDim.x; const int bx = blockIdx.x;
    const int vcu = (G % 8 == 0) ? (bx % 8) * (G / 8) + bx / 8 : bx;
    const int gw0 = vcu * NWAVES + wave0, NGW = G * NWAVES;
    for (int u = tid0; u < (LDS_BYTES - LDSCTL_OFF) / 4; u += NWAVES * 64) ((LAS unsigned*)(lds + LDSCTL_OFF))[u] = 0u;
    __syncthreads();
#if MK_PER_PHASE
    XcdBarrier bar; bar.bar = nullptr; bar.x = 0; bar.st = nullptr;
#else
    XcdBarrier bar = xcd_barrier_post((unsigned*)(argp()->ws + WS_CTL) + CW_BAR, MISC + 8);
#endif
#if MK_PER_PHASE
    const int lo = argp()->ph_lo, hi = argp()->ph_hi;
#else
    constexpr int lo = 0, hi = NPH;
#endif

    if (IN(0)) {
        ArgsP A = argp(); PH_LOCALS();
        strips_to_i8(A, lds + RING_OFF, bx, G, wave, lane);
        constexpr int NBAL = N_STRIPS % 256, BAL_TILES = (256 - NBAL) * 16;
        if (G == 256 && bx >= NBAL) cvt_range_big(A, SEG_D0 + 2 * POOL_CVT + 2 * PROJ_CVT + FGU_CVT, SEG_D0 + 2 * POOL_CVT + 2 * PROJ_CVT + FGU_CVT + BAL_TILES, (bx - NBAL) * NWAVES + wave, (256 - NBAL) * NWAVES, lane);
        if (!(G == 256 && PROJ_STGB > 0)) {
        cvt_range(A, SEG_A0 + T_WIN, SEG_B0, gw, NGW, lane);
        if (DENSE_DOWN_FP8) cvt_range_big(A, SEG_B0 + 2 * T_FF8, SEG_B0 + 3 * T_FF8, gw, NGW, lane); else cvt_range(A, SEG_B0 + 2 * T_FF8, SEG_C0, gw, NGW, lane); }
        if (G != 256) cvt_range(A, SEG_C0 + T_WIN, SEG_D0, gw, NGW, lane);
        cvt_range_big(A, G == 256 ? HK_DEND : SEG_D0, SEG_E0, gw, NGW, lane);
        const float* x = A->in[0]; const float* gn = A->in[1];
        for (int m = gw; m < M; m += 4 * NGW) rms_rows_to_i8<4>(x, gn, WSP(unsigned char, WS_H), WSP(float, WS_TOK + 262144), m, NGW, lane);
    }
    SEAM(0);

    layer_phases<0>(lds, G, bx, vcu, gw0, wave0, NGW, lo, hi, bar);
    layer_phases<1>(lds, G, bx, vcu, gw0, wave0, NGW, lo, hi, bar);
#undef IN
#undef SEAM
#undef WSP
}

extern "C" void kernel_launch(void* const* d_in, const int* in_sizes, int n_in, void* d_out, int out_size, void* d_ws, size_t ws_size, hipStream_t stream) {
    static int grid = 0;
    if (grid == 0) {
        if (n_in != 17 || out_size != M * D || ws_size < WS_END) { fprintf(stderr, "kernel_launch: unexpected shapes (n_in %d out %d ws %zu)\n", n_in, out_size, ws_size); grid = -1; return; }
        int dev = 0, cus = 0, per_cu = 0;
        if (hipGetDevice(&dev) != hipSuccess || hipDeviceGetAttribute(&cus, hipDeviceAttributeMultiprocessorCount, dev) != hipSuccess) { grid = -1; return; }
        if (hipFuncSetAttribute((const void*)fwd_kernel, hipFuncAttributeMaxDynamicSharedMemorySize, LDS_BYTES) != hipSuccess) { fprintf(stderr, "kernel_launch: hipFuncSetAttribute failed\n"); grid = -1; return; }
        if (hipOccupancyMaxActiveBlocksPerMultiprocessor(&per_cu, (const void*)fwd_kernel, NWAVES * 64, LDS_BYTES) != hipSuccess || per_cu < 1) fprintf(stderr, "kernel_launch: occupancy query reports %d\n", per_cu);
        (void)hipGetLastError();
        grid = cus;
    }
    if (grid < 0) return;
    (void)hipMemsetAsync((char*)d_ws + WS_CTL, 0, CTL_ZERO_BYTES, stream);
    Args a{};
    for (int i = 0; i < 17; ++i) a.in[i] = (const float*)d_in[i];
    a.out = (float*)d_out; a.ws = (unsigned char*)d_ws;
#if MK_PER_PHASE
    for (int p = 0; p < NPH; ++p) { a.ph_lo = p; a.ph_hi = p + 1; hipLaunchKernelGGL(fwd_kernel, dim3(grid), dim3(NWAVES * 64), LDS_BYTES, stream, a); }
#else
    a.ph_lo = 0; a.ph_hi = NPH; hipLaunchKernelGGL(fwd_kernel, dim3(grid), dim3(NWAVES * 64), LDS_BYTES, stream, a);
#endif
}
```
